# Optimizing an MI355X kernel written in HIP

```python
import math
import jax, jax.numpy as jnp
from jax import lax
import numpy as np

D_MODEL = 1024
BATCH = 4
SEQ = 4096
DEPTH = 4
DEC_BATCH = 2
DEC_SEQ = 8192
PAST_LEN = 128

GRID_W = 64
MAX_WIN_H = 8
WIN_W = 16
NA_HEADS = 8
NA_HEAD_DIM = 64
NA_WIDTH = NA_HEADS * NA_HEAD_DIM
DIFF_HEADS = 4
DIFF_QK_DIM = 64
DIFF_V_DIM = 2 * DIFF_QK_DIM
DIFF_WIDTH = DIFF_HEADS * DIFF_V_DIM
MIX_WIDTH = NA_WIDTH + DIFF_WIDTH
IN_WIDTH = 3 * NA_WIDTH + DIFF_HEADS * 2 * DIFF_QK_DIM * 2 + DIFF_WIDTH
D_FF = 2816
CONV_W = 3
ROPE_THETA = 10000.0
Q_BLOCK = 128
EPS = 1e-6

kernel_name = "hybrid_natten_diffattn_encoder"


def rms_norm(x, g):
    x32 = x.astype(jnp.float32)
    y = x32 * lax.rsqrt(jnp.mean(x32 * x32, axis=-1, keepdims=True) + EPS)
    return (y * g.astype(jnp.float32)).astype(x.dtype)


def rotary(x, T):
    d = x.shape[-1]
    inv_freq = 1.0 / (ROPE_THETA ** (jnp.arange(0, d, 2, dtype=jnp.float32) / d))
    ang = jnp.arange(T, dtype=jnp.float32)[:, None] * inv_freq[None, :]
    cos = jnp.concatenate([jnp.cos(ang), jnp.cos(ang)], -1).astype(x.dtype)[None, :, None, None, :]
    sin = jnp.concatenate([jnp.sin(ang), jnp.sin(ang)], -1).astype(x.dtype)[None, :, None, None, :]
    x1, x2 = x[..., : d // 2], x[..., d // 2:]
    rot = jnp.concatenate([-x2, x1], -1)
    return x * cos + rot * sin


def neighbourhood_attention(q, k, v, rpb):
    B, T, H, dh = q.shape
    rows = T // GRID_W
    win_h = min(MAX_WIN_H, rows)
    scale = 1.0 / math.sqrt(dh)
    qg = q.reshape(B, rows, GRID_W, H, dh).transpose(1, 0, 3, 2, 4)
    kg = k.reshape(B, rows, GRID_W, H, dh).transpose(0, 3, 1, 2, 4)
    vg = v.reshape(B, rows, GRID_W, H, dh).transpose(0, 3, 1, 2, 4)
    cols = np.arange(GRID_W)
    col_start = np.clip(cols - WIN_W // 2, 0, GRID_W - WIN_W)
    col_idx = col_start[:, None] + np.arange(WIN_W)[None, :]
    dc_idx = (col_idx - cols[:, None]) + (WIN_W - 1)
    rpb32 = rpb.astype(jnp.float32)

    def one_row(args):
        r, q_row = args
        start = jnp.clip(r - win_h // 2, 0, rows - win_h)
        k_band = lax.dynamic_slice_in_dim(kg, start, win_h, axis=2)
        v_band = lax.dynamic_slice_in_dim(vg, start, win_h, axis=2)
        k_win = k_band[:, :, :, col_idx, :]
        v_win = v_band[:, :, :, col_idx, :]
        dr_idx = start + jnp.arange(win_h) - r + (MAX_WIN_H - 1)
        bias = rpb32[:, dr_idx[None, :, None], dc_idx[:, None, :]]
        s = jnp.einsum('bhcd,bhwcjd->bhcwj', q_row, k_win).astype(jnp.float32) * scale + bias[None]
        p = jax.nn.softmax(s.reshape(B, H, GRID_W, win_h * WIN_W), axis=-1)
        p = p.reshape(B, H, GRID_W, win_h, WIN_W).astype(v.dtype)
        return jnp.einsum('bhcwj,bhwcjd->bhcd', p, v_win)

    out = lax.map(one_row, (jnp.arange(rows), qg))
    return out.transpose(1, 0, 3, 2, 4).reshape(B, T, H * dh)


def diff_attention(q, k, v, lam, subln_g, lam_init):
    B, T, H, _, d = q.shape
    dv = v.shape[-1]
    scale = 1.0 / math.sqrt(d)
    nb = T // Q_BLOCK
    k1 = k[..., 0, :].transpose(0, 2, 1, 3)
    k2 = k[..., 1, :].transpose(0, 2, 1, 3)
    vh = v.transpose(0, 2, 1, 3)
    qb = q.transpose(0, 2, 1, 3, 4).reshape(B, H, nb, Q_BLOCK, 2, d).transpose(2, 0, 1, 3, 4, 5)

    def one_block(qblk):
        s1 = jnp.einsum('bhqd,bhkd->bhqk', qblk[..., 0, :], k1).astype(jnp.float32) * scale
        s2 = jnp.einsum('bhqd,bhkd->bhqk', qblk[..., 1, :], k2).astype(jnp.float32) * scale
        w = jax.nn.softmax(s1, axis=-1) - lam * jax.nn.softmax(s2, axis=-1)
        return jnp.einsum('bhqk,bhkv->bhqv', w.astype(v.dtype), vh)

    out = lax.map(one_block, qb)
    out = out.transpose(1, 0, 3, 2, 4).reshape(B, T, H, dv)
    out = rms_norm(out, subln_g) * (1.0 - lam_init)
    return out.reshape(B, T, H * dv)


def dwconv_centred(h, w, b):
    hp = jnp.pad(h, ((0, 0), (1, 1), (0, 0)))
    return hp[:, :-2] * w[0] + hp[:, 1:-1] * w[1] + hp[:, 2:] * w[2] + b


def trunk(x, g_attn, w_in, rpb, lam_q1, lam_k1, lam_q2, lam_k2, subln_g, w_out,
          g_ffn, w_up, conv_w, conv_b, w_down, g_final):
    B, T, _ = x.shape
    o_qa, o_ka, o_va = 0, NA_WIDTH, 2 * NA_WIDTH
    o_qb = 3 * NA_WIDTH
    qk_b = DIFF_HEADS * 2 * DIFF_QK_DIM
    o_kb = o_qb + qk_b
    o_vb = o_kb + qk_b
    for l in range(DEPTH):
        n = rms_norm(x, g_attn[l])
        proj = n @ w_in[l]
        qa = proj[..., o_qa:o_ka].reshape(B, T, NA_HEADS, NA_HEAD_DIM)
        ka = proj[..., o_ka:o_va].reshape(B, T, NA_HEADS, NA_HEAD_DIM)
        va = proj[..., o_va:o_qb].reshape(B, T, NA_HEADS, NA_HEAD_DIM)
        qb = proj[..., o_qb:o_kb].reshape(B, T, DIFF_HEADS, 2, DIFF_QK_DIM)
        kb = proj[..., o_kb:o_vb].reshape(B, T, DIFF_HEADS, 2, DIFF_QK_DIM)
        vb = proj[..., o_vb:].reshape(B, T, DIFF_HEADS, DIFF_V_DIM)
        qb = rotary(qb, T)
        kb = rotary(kb, T)
        lam_init = 0.8 - 0.6 * math.exp(-0.3 * l)
        lam = (jnp.exp(jnp.sum(lam_q1[l].astype(jnp.float32) * lam_k1[l].astype(jnp.float32)))
               - jnp.exp(jnp.sum(lam_q2[l].astype(jnp.float32) * lam_k2[l].astype(jnp.float32)))
               + lam_init)
        ya = neighbourhood_attention(qa, ka, va, rpb[l])
        yb = diff_attention(qb, kb, vb, lam, subln_g[l], lam_init)
        x = x + jnp.concatenate([ya, yb], axis=-1) @ w_out[l]
        n = rms_norm(x, g_ffn[l])
        u = n @ w_up[l]
        gate, val = u[..., :D_FF], u[..., D_FF:]
        gate = dwconv_centred(gate, conv_w[l], conv_b[l])
        x = x + (jax.nn.gelu(gate, approximate=False) * val) @ w_down[l]
    return rms_norm(x, g_final)


def setup_inputs(seed: int = 0) -> dict:
    key = jax.random.key(seed)
    ks = jax.random.split(key, 20)
    f32 = jnp.float32
    nrm = lambda k, s, sc: jax.random.normal(k, s, f32) * sc
    return {
        "x_prompt": nrm(ks[0], (BATCH, SEQ, D_MODEL), 1.0),
        "x_sample": nrm(ks[1], (DEC_BATCH, DEC_SEQ, D_MODEL), 1.0),
        "g_attn": 1.0 + nrm(ks[2], (DEPTH, D_MODEL), 0.02),
        "w_in": nrm(ks[3], (DEPTH, D_MODEL, IN_WIDTH), D_MODEL ** -0.5),
        "rpb": nrm(ks[4], (DEPTH, NA_HEADS, 2 * MAX_WIN_H - 1, 2 * WIN_W - 1), 0.1),
        "lam_q1": nrm(ks[5], (DEPTH, DIFF_QK_DIM), 0.1),
        "lam_k1": nrm(ks[6], (DEPTH, DIFF_QK_DIM), 0.1),
        "lam_q2": nrm(ks[7], (DEPTH, DIFF_QK_DIM), 0.1),
        "lam_k2": nrm(ks[8], (DEPTH, DIFF_QK_DIM), 0.1),
        "subln_g": 1.0 + nrm(ks[9], (DEPTH, DIFF_V_DIM), 0.02),
        "w_out": nrm(ks[10], (DEPTH, MIX_WIDTH, D_MODEL), MIX_WIDTH ** -0.5),
        "g_ffn": 1.0 + nrm(ks[11], (DEPTH, D_MODEL), 0.02),
        "w_up": nrm(ks[12], (DEPTH, D_MODEL, 2 * D_FF), D_MODEL ** -0.5),
        "conv_w": nrm(ks[13], (DEPTH, CONV_W, D_FF), CONV_W ** -0.5),
        "conv_b": nrm(ks[14], (DEPTH, D_FF), 0.01),
        "w_down": nrm(ks[15], (DEPTH, D_FF, D_MODEL), D_FF ** -0.5),
        "g_final": 1.0 + nrm(ks[16], (D_MODEL,), 0.02),
    }


def reference(x_prompt, x_sample, g_attn, w_in, rpb, lam_q1, lam_k1, lam_q2, lam_k2,
              subln_g, w_out, g_ffn, w_up, conv_w, conv_b, w_down, g_final):
    y_prompt = trunk(x_prompt, g_attn, w_in, rpb, lam_q1, lam_k1, lam_q2, lam_k2, subln_g,
                     w_out, g_ffn, w_up, conv_w, conv_b, w_down, g_final)
    y_sample = trunk(x_sample, g_attn, w_in, rpb, lam_q1, lam_k1, lam_q2, lam_k2, subln_g,
                     w_out, g_ffn, w_up, conv_w, conv_b, w_down, g_final)
    return (y_prompt, y_sample)
```

```cpp
#include <hip/hip_runtime.h>
#include <hip/hip_cooperative_groups.h>
#include <cstdio>
#include <cstdint>
namespace cg = cooperative_groups;

#define LAS __attribute__((address_space(3)))
typedef unsigned short bf16_t;
typedef short bf16x8 __attribute__((ext_vector_type(8)));
typedef short s16x4 __attribute__((ext_vector_type(4)));
typedef float f32x4 __attribute__((ext_vector_type(4)));
typedef float f32x2 __attribute__((ext_vector_type(2)));
typedef float f32x16 __attribute__((ext_vector_type(16)));
typedef unsigned u32x4 __attribute__((ext_vector_type(4)));
typedef unsigned u32x2 __attribute__((ext_vector_type(2)));

constexpr int M_TOK = 32768, M_PROMPT = 16384, T_P = 4096, T_S = 8192;
constexpr int DM = 1024, NQKV = 3072, DFF = 2816, NUP = 5632, DEPTH = 4;
constexpr float EPS = 1e-6f;
constexpr float LOG2E = 1.4426950408889634f;
constexpr float QSCALE = 0.125f * LOG2E;
constexpr int C_QA = 0, C_QB = 512, C_KA = 1024, C_VA = 1536, C_KB = 2048, C_VB = 2560;

constexpr size_t MiB = 1u << 20;
constexpr size_t WS_QKV = 0;
constexpr size_t WS_XB = 192 * MiB;
constexpr size_t WS_W = 256 * MiB;
constexpr size_t W_IN = 0, W_OUT = (size_t)NQKV * DM * 2, W_UP = W_OUT + (size_t)DM * DM * 2, W_DOWN = W_UP + (size_t)NUP * DM * 2;
constexpr size_t W_LAYER = W_DOWN + (size_t)DM * DFF * 2;
constexpr size_t WS_HB = WS_W + 2 * W_LAYER;
constexpr size_t HB_BYTES = (size_t)1024 * 3 * DFF * 4;
constexpr size_t WS_SSQ = WS_HB + HB_BYTES;
constexpr size_t SSQ_STAGE = (size_t)M_TOK * 16;
constexpr size_t WS_ROPE = WS_SSQ + (size_t)9 * SSQ_STAGE * 4;
constexpr size_t WS_CTL = WS_ROPE + (size_t)8192 * 32 * 8;
constexpr size_t CTL_BYTES = 16384;
constexpr size_t WS_END = WS_CTL + CTL_BYTES;

constexpr int LDS_BYTES = 163840;
constexpr int A_OFF_V = 0  , A_OFF_K = 49152  , A_OFF_WS = 81920, A_OFF_Q = 83968, A_OFF_BIAS = 83968  ;

__device__ __forceinline__ unsigned cvt_pk_bf16(float lo, float hi) { unsigned r; asm volatile("v_cvt_pk_bf16_f32 %0, %1, %2" : "=v"(r) : "v"(lo), "v"(hi)); return r; }
__device__ __forceinline__ int opaque_tid(int wave_s) { int ln; asm volatile("v_mbcnt_lo_u32_b32 %0, -1, 0\n\tv_mbcnt_hi_u32_b32 %0, -1, %0" : "=v"(ln)); return wave_s * 64 + ln; }
__device__ __forceinline__ int opaque_s(int v) { asm volatile("" : "+s"(v)); return v; }
template <int XOR> __device__ __forceinline__ float swz_xor(float v) { return __int_as_float(__builtin_amdgcn_ds_swizzle(__float_as_int(v), (XOR << 10) | 0x1f)); }
__device__ __forceinline__ float rstd_of(float ssq) { return __builtin_amdgcn_rsqf(ssq * (1.0f / DM) + EPS); }
__device__ __forceinline__ float rstd_row(const float* ssqp, int row) {
    const f32x4* p = (const f32x4*)(ssqp + (size_t)row * 16); const f32x4 a = p[0], b = p[1], c = p[2], d = p[3];
    const float s = (((a[0] + a[1]) + (a[2] + a[3])) + ((b[0] + b[1]) + (b[2] + b[3]))) + (((c[0] + c[1]) + (c[2] + c[3])) + ((d[0] + d[1]) + (d[2] + d[3])));
    return rstd_of(s);
}
__device__ __forceinline__ float rstd_lds(const LAS float* st, int r) {
    const LAS f32x4* p = (const LAS f32x4*)(st + r * 16); const f32x4 a = p[0], b = p[1], c = p[2], d = p[3];
    const float s = (((a[0] + a[1]) + (a[2] + a[3])) + ((b[0] + b[1]) + (b[2] + b[3]))) + (((c[0] + c[1]) + (c[2] + c[3])) + ((d[0] + d[1]) + (d[2] + d[3])));
    return rstd_of(s);
}
__device__ __forceinline__ int tok_pos(int row) { return row < M_PROMPT ? (row & (T_P - 1)) : (row & (T_S - 1)); }

__device__ __forceinline__ f32x2 gelu_pk(f32x2 v) {
    const f32x2 av = __builtin_elementwise_abs(v), d = av * 0.2316418882f + 1.0f;
    f32x2 t; t.x = __builtin_amdgcn_rcpf(d.x); t.y = __builtin_amdgcn_rcpf(d.y);
    f32x2 q = t * 0.5307027145f + (-0.7265760135f); q = q * t + 0.7107068705f; q = q * t + (-0.142248368f); q = q * t + 0.127414796f; q = q * t;
    const f32x2 s = (v * v) * (-0.72134752044f);
    f32x2 e; e.x = __builtin_amdgcn_exp2f(s.x); e.y = __builtin_amdgcn_exp2f(s.y);
    const f32x2 m = v * (q * e), r = v - m;
    f32x2 o; o.x = v.x < 0.f ? m.x : r.x; o.y = v.y < 0.f ? m.y : r.y; return o;
}
__device__ __forceinline__ f32x4 gelu4(f32x4 v) { f32x2 a = gelu_pk((f32x2){v[0], v[1]}), b = gelu_pk((f32x2){v[2], v[3]}); return (f32x4){a.x, a.y, b.x, b.y}; }

namespace pg8 {
constexpr int BM = 256, BK = 64, HALF = 128, HTB = HALF * BK * 2, STAGE_BYTES = 8 * HTB, NXCD = 8, WGM = 8;
__host__ __device__ __forceinline__ int lds_byte(int r, int c) { const int st = (r >> 4) * 2 + (c >> 5), rr = r & 15, cc = c & 31, ob = rr * 64 + cc * 2; return st * 1024 + (ob ^ (((ob >> 9) & 1) << 5)); }
__host__ __device__ __forceinline__ void stage_rc(int b, int& R, int& C) { const int st = b / 1024, sb = b % 1024, swz = sb ^ (((sb >> 9) & 1) << 5); R = (st >> 1) * 16 + swz / 64; C = (st & 1) * 32 + (swz % 64) / 2; }
__host__ __device__ __forceinline__ int perm32(int rho) { const int n = rho >> 4, i = rho & 15; return 8 * (i >> 2) + 4 * n + (i & 3); }
struct Unit { int pm, pn; };
struct Gemm { const bf16_t* A; const bf16_t* Bt; int M, N, K, lda; };
struct StaticOrder {
    int nM, nN, nwg, G, c;
    __device__ void init(int M, int N, int G_, int c_) { nM = M / BM; nN = N / BM; nwg = nM * nN; G = G_; c = c_; }
    __device__ bool next(int i, Unit& u) const {
        const long L = (long)i * G + c; if (L >= nwg) return false;
        int wgid = (int)L; { const int q = nwg / NXCD, r = nwg % NXCD, xcd = wgid % NXCD, off = wgid / NXCD; wgid = (xcd < r ? xcd * (q + 1) : r * (q + 1) + (xcd - r) * q) + off; }
        const int nig = WGM * nN, gid = wgid / nig, fm = gid * WGM, gsz = (nM - fm) < WGM ? (nM - fm) : WGM;
        u.pm = fm + ((wgid % nig) % gsz); u.pn = (wgid % nig) / gsz; return true;
    }
};
template <class Epi>
__device__ __forceinline__ void gemm_phase(LAS unsigned char* lds, const Gemm g, const StaticOrder& S, const Epi& E, int wave_s) {
    const int tid = opaque_tid(wave_s), wid = __builtin_amdgcn_readfirstlane(tid >> 6), lane = tid & 63, wr = wid >> 2, wc = wid & 3, fr = lane & 15, fq = lane >> 4;
    const int K = g.K, nt = K / BK, lda = g.lda;
    unsigned voffA[2], voffB[2];
#pragma unroll
    for (int i = 0; i < 2; ++i) { int R, C; stage_rc(tid * 16 + i * 8192, R, C); const int Rb = (R & ~31) + perm32(R & 31);
        voffA[i] = (unsigned)(R * lda + C) * 2u; voffB[i] = (unsigned)(Rb * K + C) * 2u; }
    const size_t kstep = (size_t)(BK * 2);
    const size_t hstepA = (size_t)HALF * lda * 2, hstepB = (size_t)HALF * K * 2;
    const size_t tstepA = 2 * hstepA, tstepB = 2 * hstepB;
    const unsigned ldsw = (unsigned)wid * 1024u;
    const int aoff = lds_byte(wr * 64 + fr, fq * 8), boff = lds_byte(wc * 32 + fr, fq * 8);
#define PG8_SA(b, h) (((b) * 2 + (h)) * HTB)
#define PG8_SB(b, h) ((4 + (b) * 2 + (h)) * HTB)
#define PG8_STAGE(bufoff, gbase, voff) do { _Pragma("unroll") for (int _i = 0; _i < 2; ++_i) \
        __builtin_amdgcn_global_load_lds((const unsigned*)((const char*)(gbase) + (voff)[_i]), (LAS unsigned*)(lds + (bufoff) + ldsw + _i * 8192), 16, 0, 0); } while (0)
#define PG8_LDA(dst, b, h) do { _Pragma("unroll") for (int m = 0; m < 4; ++m) _Pragma("unroll") for (int k = 0; k < 2; ++k) dst[m][k] = *(const LAS bf16x8*)(lds + PG8_SA(b, h) + aoff + m * 2048 + k * 1024); } while (0)
#define PG8_LDB(dst, b, h) do { _Pragma("unroll") for (int n = 0; n < 2; ++n) _Pragma("unroll") for (int k = 0; k < 2; ++k) dst[n][k] = *(const LAS bf16x8*)(lds + PG8_SB(b, h) + boff + n * 2048 + k * 1024); } while (0)
#define PG8_MMA(ai, bj, At, Bt) do { __builtin_amdgcn_s_setprio(1); _Pragma("unroll") for (int m = 0; m < 4; ++m) _Pragma("unroll") for (int n = 0; n < 2; ++n) _Pragma("unroll") for (int k = 0; k < 2; ++k) \
        acc[ai][bj][m][n] = __builtin_amdgcn_mfma_f32_16x16x32_bf16(Bt[n][k], At[m][k], acc[ai][bj][m][n], 0, 0, 0); __builtin_amdgcn_s_setprio(0); } while (0)
#define PG8_WAIT_V(n) asm volatile("s_waitcnt vmcnt(" #n ")" ::: "memory")
#define PG8_WAIT_L(n) asm volatile("s_waitcnt lgkmcnt(" #n ")" ::: "memory")
#define PG8_BAR __builtin_amdgcn_s_barrier()
#define PG8_SCHED __builtin_amdgcn_sched_barrier(0)
    Unit cur, nxt; int ui = 0;
    if (!S.next(0, cur)) return;
    const unsigned stoff = (unsigned)(((lane >> 2) * 16 + (lane & 3) * 4) * 4);
#define PG8_STATS(pm_, buf_) do { if constexpr (Epi::STATS) { const char* sp_ = (const char*)E.ssq + ((size_t)(pm_) * 256 + wid * 32) * 64; \
        __builtin_amdgcn_global_load_lds((const unsigned*)(sp_ + stoff), (LAS unsigned*)(lds + 131072 + (buf_) * 16384 + wid * 2048), 16, 0, 0); \
        __builtin_amdgcn_global_load_lds((const unsigned*)(sp_ + 1024 + stoff), (LAS unsigned*)(lds + 131072 + (buf_) * 16384 + wid * 2048 + 1024), 16, 0, 0); } } while (0)
    PG8_STATS(cur.pm, 0);
    f32x4 acc[2][2][4][2];
#pragma unroll
    for (int a = 0; a < 2; ++a)
#pragma unroll
        for (int b = 0; b < 2; ++b)
#pragma unroll
            for (int m = 0; m < 4; ++m)
#pragma unroll
                for (int n = 0; n < 2; ++n) acc[a][b][m][n] = (f32x4){0.f, 0.f, 0.f, 0.f};
    bf16x8 At[4][2], B0[2][2], B1[2][2];
    const char* cA = (const char*)g.A + (size_t)cur.pm * tstepA; const char* cB = (const char*)g.Bt + (size_t)cur.pn * tstepB;
    PG8_STAGE(PG8_SB(0, 0), cB, voffB); PG8_STAGE(PG8_SB(0, 1), cB + hstepB, voffB); PG8_STAGE(PG8_SA(0, 0), cA, voffA); PG8_STAGE(PG8_SA(0, 1), cA + hstepA, voffA);
    if (wr == 1) PG8_BAR;
    PG8_WAIT_V(2); PG8_BAR;
    PG8_STAGE(PG8_SB(1, 0), cB + kstep, voffB); PG8_STAGE(PG8_SA(1, 0), cA + kstep, voffA); PG8_STAGE(PG8_SB(1, 1), cB + hstepB + kstep, voffB);
    PG8_WAIT_V(6); PG8_BAR;
    for (;;) {
        const bool has_next = S.next(ui + 1, nxt);
        const char* nA = has_next ? (const char*)g.A + (size_t)nxt.pm * tstepA : cA; const char* nB = has_next ? (const char*)g.Bt + (size_t)nxt.pn * tstepB : cB;
        for (int t = 0; t < nt; t += 2) {
            const bool last = (t == nt - 2);
            const char* a1 = cA + (size_t)(t + 1) * kstep;
            const char* a2 = last ? nA : cA + (size_t)(t + 2) * kstep; const char* b2 = last ? nB : cB + (size_t)(t + 2) * kstep;
            const char* a3 = a2 + kstep; const char* b3 = b2 + kstep;
            PG8_LDB(B0, 0, 0); PG8_LDB(B1, 0, 1); PG8_SCHED; PG8_LDA(At, 0, 0); PG8_STAGE(PG8_SA(1, 1), a1 + hstepA, voffA);
            PG8_WAIT_V(8); PG8_WAIT_L(0); PG8_BAR; PG8_MMA(0, 0, At, B0); PG8_MMA(0, 1, At, B1); PG8_BAR; PG8_SCHED;
            PG8_LDA(At, 0, 1); PG8_STAGE(PG8_SB(0, 0), b2, voffB); PG8_STAGE(PG8_SB(0, 1), b2 + hstepB, voffB); PG8_STAGE(PG8_SA(0, 0), a2, voffA);
            PG8_WAIT_V(8); PG8_WAIT_L(0); PG8_BAR; PG8_MMA(1, 0, At, B0); PG8_MMA(1, 1, At, B1); PG8_BAR; PG8_SCHED;
            PG8_LDB(B0, 1, 0); PG8_LDB(B1, 1, 1); PG8_SCHED; PG8_LDA(At, 1, 0); PG8_STAGE(PG8_SA(0, 1), a2 + hstepA, voffA);
            PG8_WAIT_V(8); PG8_WAIT_L(0); PG8_BAR; PG8_MMA(0, 0, At, B0); PG8_MMA(0, 1, At, B1); PG8_BAR; PG8_SCHED;
            PG8_LDA(At, 1, 1); PG8_STAGE(PG8_SB(1, 0), b3, voffB); PG8_STAGE(PG8_SB(1, 1), b3 + hstepB, voffB); PG8_STAGE(PG8_SA(1, 0), a3, voffA);
            PG8_WAIT_V(8); PG8_WAIT_L(0); PG8_BAR; PG8_MMA(1, 0, At, B0); PG8_MMA(1, 1, At, B1); PG8_BAR; PG8_SCHED;
        }
        if (wr == 0) PG8_BAR;
        E(acc, cur, wr, wc, fr, fq, (const LAS float*)(lds + 131072 + (ui & 1) * 16384));
        if (!has_next) break;
#pragma unroll
        for (int a = 0; a < 2; ++a)
#pragma unroll
            for (int b = 0; b < 2; ++b)
#pragma unroll
                for (int m = 0; m < 4; ++m)
#pragma unroll
                    for (int n = 0; n < 2; ++n) acc[a][b][m][n] = (f32x4){0.f, 0.f, 0.f, 0.f};
        cur = nxt; cA = nA; cB = nB; ++ui;
        PG8_STATS(cur.pm, ui & 1);
        if (wr == 1) PG8_BAR;
    }
    PG8_WAIT_V(0);
    PG8_BAR;
#undef PG8_STATS
#undef PG8_SA
#undef PG8_SB
#undef PG8_STAGE
#undef PG8_LDA
#undef PG8_LDB
#undef PG8_MMA
#undef PG8_WAIT_V
#undef PG8_WAIT_L
#undef PG8_BAR
#undef PG8_SCHED
}
}

struct EpiInProj {
    static constexpr bool STATS = true;
    bf16_t* O; const float* ssq; const f32x2* rope;
    __device__ __forceinline__ void operator()(const f32x4 (&acc)[2][2][4][2], const pg8::Unit& u, int wr, int wc, int fr, int fq, const LAS float* stats) const {
        const int pn = u.pn; const bool rot = (pn == 2 || pn == 3 || pn == 8 || pn == 9); const float qs = pn < 4 ? QSCALE : 1.0f;
        const int rl0 = wr * 64 + fr, row0 = u.pm * 256 + rl0;
        const int cin = wc * 32 + 8 * fq;
#pragma unroll
        for (int ai = 0; ai < 2; ++ai) {
#pragma unroll
          for (int mp = 0; mp < 2; ++mp) {
            f32x4 rc[4][2][2];
            if (rot) {
#pragma unroll
                for (int m = 2 * mp; m < 2 * mp + 2; ++m) { const int t = tok_pos(row0 + ai * 128 + m * 16);
#pragma unroll
                    for (int bj = 0; bj < 2; ++bj) { const f32x4* rp = (const f32x4*)(rope + (size_t)t * 32 + (((bj * 128 + cin) & 63) >> 1)); rc[m][bj][0] = rp[0]; rc[m][bj][1] = rp[1]; } }
            }
#pragma unroll
            for (int m = 2 * mp; m < 2 * mp + 2; ++m) {
                const int row = row0 + ai * 128 + m * 16; const float rs = rstd_lds(stats, rl0 + ai * 128 + m * 16) * qs;
#pragma unroll
                for (int bj = 0; bj < 2; ++bj) {
                    const int col0 = pn * 256 + bj * 128 + cin;
                    f32x4 v0 = acc[ai][bj][m][0] * rs, v1 = acc[ai][bj][m][1] * rs;
                    if (rot) {
                        const f32x4 c0 = rc[m][bj][0], c1 = rc[m][bj][1];
                        f32x4 w0, w1;
                        w0[0] = v0[0] * c0[0] - v0[1] * c0[1]; w0[1] = v0[1] * c0[0] + v0[0] * c0[1];
                        w0[2] = v0[2] * c0[2] - v0[3] * c0[3]; w0[3] = v0[3] * c0[2] + v0[2] * c0[3];
                        w1[0] = v1[0] * c1[0] - v1[1] * c1[1]; w1[1] = v1[1] * c1[0] + v1[0] * c1[1];
                        w1[2] = v1[2] * c1[2] - v1[3] * c1[3]; w1[3] = v1[3] * c1[2] + v1[2] * c1[3];
                        v0 = w0; v1 = w1;
                    }
                    u32x4 w; w.x = cvt_pk_bf16(v0[0], v0[1]); w.y = cvt_pk_bf16(v0[2], v0[3]); w.z = cvt_pk_bf16(v1[0], v1[1]); w.w = cvt_pk_bf16(v1[2], v1[3]);
                    *(u32x4*)(O + (size_t)row * NQKV + col0) = w;
                }
            }
            __builtin_amdgcn_sched_barrier(0);
          }
        }
    }
};
struct EpiResid {
    static constexpr bool STATS = false;
    bf16_t* XB; float* ssq_next;
    __device__ __forceinline__ void operator()(const f32x4 (&acc)[2][2][4][2], const pg8::Unit& u, int wr, int wc, int fr, int fq, const LAS float*) const {
        const int row0 = u.pm * 256 + wr * 64 + fr; const int colb = u.pn * 256 + wc * 32 + 8 * fq;
#pragma unroll
        for (int ai = 0; ai < 2; ++ai) {
            u32x4 xo[4][2];
#pragma unroll
            for (int m = 0; m < 4; ++m)
#pragma unroll
                for (int bj = 0; bj < 2; ++bj) xo[m][bj] = *(const u32x4*)(XB + (size_t)(row0 + ai * 128 + m * 16) * DM + colb + bj * 128);
#pragma unroll
            for (int m = 0; m < 4; ++m) {
                const int row = row0 + ai * 128 + m * 16; float s = 0.f;
#pragma unroll
                for (int bj = 0; bj < 2; ++bj) {
                    const u32x4 o = xo[m][bj]; const f32x4 a0 = acc[ai][bj][m][0], a1 = acc[ai][bj][m][1];
                    u32x4 w;
                    w.x = cvt_pk_bf16(__uint_as_float(o.x << 16) + a0[0], __uint_as_float(o.x & 0xffff0000u) + a0[1]);
                    w.y = cvt_pk_bf16(__uint_as_float(o.y << 16) + a0[2], __uint_as_float(o.y & 0xffff0000u) + a0[3]);
                    w.z = cvt_pk_bf16(__uint_as_float(o.z << 16) + a1[0], __uint_as_float(o.z & 0xffff0000u) + a1[1]);
                    w.w = cvt_pk_bf16(__uint_as_float(o.w << 16) + a1[2], __uint_as_float(o.w & 0xffff0000u) + a1[3]);
                    *(u32x4*)(XB + (size_t)row * DM + colb + bj * 128) = w;
                    const float r0 = __uint_as_float(w.x << 16), r1 = __uint_as_float(w.x & 0xffff0000u), r2 = __uint_as_float(w.y << 16), r3 = __uint_as_float(w.y & 0xffff0000u);
                    const float r4 = __uint_as_float(w.z << 16), r5 = __uint_as_float(w.z & 0xffff0000u), r6 = __uint_as_float(w.w << 16), r7 = __uint_as_float(w.w & 0xffff0000u);
                    s += ((r0 * r0 + r1 * r1) + (r2 * r2 + r3 * r3)) + ((r4 * r4 + r5 * r5) + (r6 * r6 + r7 * r7));
                }
                s += swz_xor<16>(s);
                { auto rr = __builtin_amdgcn_permlane32_swap(__float_as_uint(s), __float_as_uint(s), false, false); s = __uint_as_float(rr[0]) + __uint_as_float(rr[1]); }
                if (fq == 0) ssq_next[(size_t)row * 16 + u.pn * 4 + wc] = s;
            }
        }
    }
};
struct EpiUp {
    static constexpr bool STATS = true;
    bf16_t* H; float* HB; const float* ssq; const float* cw; const float* cb;
    __device__ __forceinline__ void operator()(const f32x4 (&acc)[2][2][4][2], const pg8::Unit& u, int wr, int wc, int fr, int fq, const LAS float* stats) const {
        const int ffc0 = u.pn * 128 + wc * 32 + 8 * fq;
        const unsigned long long is0 = __ballot(fr == 0), is15 = __ballot(fr == 15);
#pragma unroll
        for (int ai = 0; ai < 2; ++ai) {
            const int rowbase = u.pm * 256 + ai * 128 + wr * 64; const int grp = rowbase >> 6;
            float rs[4];
#pragma unroll
            for (int m = 0; m < 4; ++m) rs[m] = rstd_lds(stats, ai * 128 + wr * 64 + 16 * m + fr);
            u32x2 keep[4];
#pragma unroll
            for (int n = 0; n < 2; ++n) {
                const f32x4 w0 = *(const f32x4*)(cw + ffc0 + 4 * n), w1 = *(const f32x4*)(cw + DFF + ffc0 + 4 * n), w2 = *(const f32x4*)(cw + 2 * DFF + ffc0 + 4 * n), bb = *(const f32x4*)(cb + ffc0 + 4 * n);
                f32x4 g[4], R[4], Lr[4], up4[4], dn4[4];
#pragma unroll
                for (int m = 0; m < 4; ++m) { g[m] = acc[ai][0][m][n] * rs[m];
#pragma unroll
                    for (int e = 0; e < 4; ++e) { R[m][e] = __int_as_float(__builtin_amdgcn_update_dpp(0, __float_as_int(g[m][e]), 0x121, 0xf, 0xf, false));
                        Lr[m][e] = __int_as_float(__builtin_amdgcn_update_dpp(0, __float_as_int(g[m][e]), 0x12F, 0xf, 0xf, false)); } }
#pragma unroll
                for (int m = 0; m < 4; ++m)
#pragma unroll
                    for (int e = 0; e < 4; ++e) {
                        float a = R[m][e], b = R[m > 0 ? m - 1 : 0][e], c = Lr[m][e], d = Lr[m < 3 ? m + 1 : 3][e];
                        asm volatile("v_cndmask_b32 %0, %1, %2, %3" : "=v"(up4[m][e]) : "v"(a), "v"(b), "s"(is0));
                        asm volatile("v_cndmask_b32 %0, %1, %2, %3" : "=v"(dn4[m][e]) : "v"(c), "v"(d), "s"(is15));
                    }
#pragma unroll
                for (int m = 0; m < 4; ++m) {
                    const f32x4 v = acc[ai][1][m][n] * rs[m];
                    const f32x4 up = up4[m];
                    const f32x4 dn = dn4[m];
                    const bool first = (m == 0) && (fr == 0), last = (m == 3) && (fr == 15);
                    f32x4 x = w1 * g[m] + bb;
                    if (!first) x += w0 * up;
                    if (!last) x += w2 * dn;
                    if (first || last) {
                        float* hb = HB + (size_t)((grp * 2 + (last ? 1 : 0)) * 3) * DFF + ffc0 + 4 * n;
                        *(f32x4*)hb = x; *(f32x4*)(hb + DFF) = v; *(f32x4*)(hb + 2 * DFF) = g[m];
                    } else {
                        const f32x4 hv = gelu4(x) * v;
                        u32x2 w; w.x = cvt_pk_bf16(hv[0], hv[1]); w.y = cvt_pk_bf16(hv[2], hv[3]);
                        if (n == 0) keep[m] = w;
                        else { u32x4 w4; w4.x = keep[m].x; w4.y = keep[m].y; w4.z = w.x; w4.w = w.y; *(u32x4*)(H + (size_t)(rowbase + 16 * m + fr) * DFF + ffc0) = w4; }
                    }
                }
                __builtin_amdgcn_sched_barrier(0);
            }
        }
    }
};

namespace att {
constexpr float THRL = 10.f;
#define KSWZ(row, colB) ((row) * 256 + ((colB) ^ (((row) & 15) << 4)))
#define SBAR() __builtin_amdgcn_sched_barrier(0)
__device__ __forceinline__ int crow(int r, int hi) { return (r & 3) + 8 * (r >> 2) + 4 * hi; }
__device__ __forceinline__ void softmax_tile(f32x16& p0, f32x16& p1, float& m_reg, float& l_reg, float& alpha, bf16x8& pa0, bf16x8& pa1, bf16x8& pa2, bf16x8& pa3) {
    float pmax = p0[0];
#pragma unroll
    for (int r = 1; r < 16; ++r) pmax = fmaxf(pmax, p0[r]);
#pragma unroll
    for (int r = 0; r < 16; ++r) pmax = fmaxf(pmax, p1[r]);
    { auto rr = __builtin_amdgcn_permlane32_swap(__float_as_uint(pmax), __float_as_uint(pmax), false, false);
      pmax = fmaxf(__uint_as_float(rr[0]), __uint_as_float(rr[1])); }
    float mn;
    if (__builtin_expect(__all(pmax - m_reg <= THRL), 1)) { mn = m_reg; alpha = 1.f; }
    else { mn = fmaxf(m_reg, pmax); alpha = __builtin_amdgcn_exp2f(m_reg - mn); m_reg = mn; }
#pragma unroll
    for (int r = 0; r < 16; ++r) p0[r] = __builtin_amdgcn_exp2f(p0[r] - mn);
#pragma unroll
    for (int r = 0; r < 16; ++r) p1[r] = __builtin_amdgcn_exp2f(p1[r] - mn);
    float ps = 0;
#pragma unroll
    for (int r = 0; r < 16; ++r) ps += p0[r];
#pragma unroll
    for (int r = 0; r < 16; ++r) ps += p1[r];
    { auto rr = __builtin_amdgcn_permlane32_swap(__float_as_uint(ps), __float_as_uint(ps), false, false);
      ps = __uint_as_float(rr[0]) + __uint_as_float(rr[1]); }
    l_reg = l_reg * alpha + ps;
#define PK4(P, BASE, OUT) do { unsigned a0 = cvt_pk_bf16(P[BASE + 0], P[BASE + 1]), a1 = cvt_pk_bf16(P[BASE + 2], P[BASE + 3]);   \
    unsigned b0 = cvt_pk_bf16(P[BASE + 4], P[BASE + 5]), b1 = cvt_pk_bf16(P[BASE + 6], P[BASE + 7]);                              \
    auto r0 = __builtin_amdgcn_permlane32_swap(a0, b0, false, false); auto r1 = __builtin_amdgcn_permlane32_swap(a1, b1, false, false); \
    u32x4 w = {r0[0], r1[0], r0[1], r1[1]}; OUT = __builtin_bit_cast(bf16x8, w); } while (0)
    PK4(p0, 0, pa0); PK4(p0, 8, pa1); PK4(p1, 0, pa2); PK4(p1, 8, pa3);
#undef PK4
}
__device__ __forceinline__ void qkt4(f32x16& p0, f32x16& p1, const LAS unsigned char* Ks, const bf16x8* qr, int dc0, int r32, int hi) {
    p0 = f32x16{}; p1 = f32x16{};
#pragma unroll
    for (int d0 = 0; d0 < 4; ++d0) { const int cb = ((dc0 + d0) * 16 + hi * 8) * 2;
        const bf16x8 b0 = *(const LAS bf16x8*)(Ks + KSWZ(r32, cb));
        const bf16x8 b1 = *(const LAS bf16x8*)(Ks + KSWZ(32 + r32, cb));
        p0 = __builtin_amdgcn_mfma_f32_32x32x16_bf16(b0, qr[d0], p0, 0, 0, 0);
        p1 = __builtin_amdgcn_mfma_f32_32x32x16_bf16(b1, qr[d0], p1, 0, 0, 0); }
}
__device__ __forceinline__ int v_rd_base(int lane) { return ((lane & 3) << 3) | (((lane >> 2) & 3) << 6) | (((lane >> 4) & 1) << 5) | (((lane >> 5) & 1) << 8); }
constexpr int v_rd_off(int d0, int ks, int half) { return d0 * 512 + ks * 4096 + half * 2048; }
template <int OFF> __device__ __forceinline__ s16x4 tr_read(int vb) {
    s16x4 r; asm volatile("ds_read_b64_tr_b16 %0, %1 offset:%2" : "=&v"(r) : "v"(vb), "i"(OFF) : "memory"); return r;
}
#define PKV(L, H) (bf16x8){L[0], L[1], L[2], L[3], H[0], H[1], H[2], H[3]}
template <int D0> __device__ __forceinline__ void pv_two(f32x16& oa, f32x16& ob, int vb, const bf16x8 (&pa)[4], const bf16x8 (&pb)[4]) {
    const s16x4 l0 = tr_read<v_rd_off(D0, 0, 0)>(vb), h0 = tr_read<v_rd_off(D0, 0, 1)>(vb), l1 = tr_read<v_rd_off(D0, 1, 0)>(vb), h1 = tr_read<v_rd_off(D0, 1, 1)>(vb);
    const s16x4 l2 = tr_read<v_rd_off(D0, 2, 0)>(vb), h2 = tr_read<v_rd_off(D0, 2, 1)>(vb), l3 = tr_read<v_rd_off(D0, 3, 0)>(vb), h3 = tr_read<v_rd_off(D0, 3, 1)>(vb);
    asm volatile("s_waitcnt lgkmcnt(0)" ::: "memory"); SBAR();
    oa = __builtin_amdgcn_mfma_f32_32x32x16_bf16(pa[0], PKV(l0, h0), oa, 0, 0, 0); ob = __builtin_amdgcn_mfma_f32_32x32x16_bf16(pb[0], PKV(l0, h0), ob, 0, 0, 0);
    oa = __builtin_amdgcn_mfma_f32_32x32x16_bf16(pa[1], PKV(l1, h1), oa, 0, 0, 0); ob = __builtin_amdgcn_mfma_f32_32x32x16_bf16(pb[1], PKV(l1, h1), ob, 0, 0, 0);
    oa = __builtin_amdgcn_mfma_f32_32x32x16_bf16(pa[2], PKV(l2, h2), oa, 0, 0, 0); ob = __builtin_amdgcn_mfma_f32_32x32x16_bf16(pb[2], PKV(l2, h2), ob, 0, 0, 0);
    oa = __builtin_amdgcn_mfma_f32_32x32x16_bf16(pa[3], PKV(l3, h3), oa, 0, 0, 0); ob = __builtin_amdgcn_mfma_f32_32x32x16_bf16(pb[3], PKV(l3, h3), ob, 0, 0, 0);
}
template <int D0> __device__ __forceinline__ void pv_one(f32x16& oa, int vb, const bf16x8 (&pa)[4]) {
    const s16x4 l0 = tr_read<v_rd_off(D0, 0, 0)>(vb), h0 = tr_read<v_rd_off(D0, 0, 1)>(vb), l1 = tr_read<v_rd_off(D0, 1, 0)>(vb), h1 = tr_read<v_rd_off(D0, 1, 1)>(vb);
    const s16x4 l2 = tr_read<v_rd_off(D0, 2, 0)>(vb), h2 = tr_read<v_rd_off(D0, 2, 1)>(vb), l3 = tr_read<v_rd_off(D0, 3, 0)>(vb), h3 = tr_read<v_rd_off(D0, 3, 1)>(vb);
    asm volatile("s_waitcnt lgkmcnt(0)" ::: "memory"); SBAR();
    oa = __builtin_amdgcn_mfma_f32_32x32x16_bf16(pa[0], PKV(l0, h0), oa, 0, 0, 0);
    oa = __builtin_amdgcn_mfma_f32_32x32x16_bf16(pa[1], PKV(l1, h1), oa, 0, 0, 0);
    oa = __builtin_amdgcn_mfma_f32_32x32x16_bf16(pa[2], PKV(l2, h2), oa, 0, 0, 0);
    oa = __builtin_amdgcn_mfma_f32_32x32x16_bf16(pa[3], PKV(l3, h3), oa, 0, 0, 0);
}
template <int HALF>
__device__ __forceinline__ void na_tile(f32x16& p0, f32x16& p1, const LAS float* bl, int relb, float& m_reg, float& l_reg, float& alpha, bf16x8 (&pa)[3]) {
    f32x16& F = HALF ? p1 : p0; f32x16& S = HALF ? p0 : p1;
    constexpr int SB = HALF ? 12 : 0, FT = HALF ? 32 : 0, ST = HALF ? 0 : 32;
#pragma unroll
    for (int rr = 0; rr < 16; ++rr) { const int kc = FT + (rr & 3) + 8 * (rr >> 2); const float b = bl[kc]; const bool ok = (unsigned)(kc + relb) < 16u; F[rr] = ok ? F[rr] + b : -INFINITY; }
#pragma unroll
    for (int i = 0; i < 4; ++i) { const int rr = SB + i; const int kc = ST + (rr & 3) + 8 * (rr >> 2); const float b = bl[kc]; const bool ok = (unsigned)(kc + relb) < 16u; S[rr] = ok ? S[rr] + b : -INFINITY; }
    float pmax = F[0];
#pragma unroll
    for (int r = 1; r < 16; ++r) pmax = fmaxf(pmax, F[r]);
#pragma unroll
    for (int i = 0; i < 4; ++i) pmax = fmaxf(pmax, S[SB + i]);
    { auto rr = __builtin_amdgcn_permlane32_swap(__float_as_uint(pmax), __float_as_uint(pmax), false, false);
      pmax = fmaxf(__uint_as_float(rr[0]), __uint_as_float(rr[1])); }
    float mn;
    if (__builtin_expect(__all(pmax - m_reg <= THRL), 1)) { mn = m_reg; alpha = 1.f; }
    else { mn = fmaxf(m_reg, pmax); alpha = __builtin_amdgcn_exp2f(m_reg - mn); m_reg = mn; }
    float ps = 0;
#pragma unroll
    for (int r = 0; r < 16; ++r) { F[r] = __builtin_amdgcn_exp2f(F[r] - mn); ps += F[r]; }
#pragma unroll
    for (int i = 0; i < 4; ++i) { S[SB + i] = __builtin_amdgcn_exp2f(S[SB + i] - mn); ps += S[SB + i]; S[(SB ^ 4) + i] = 0.f; }
    { auto rr = __builtin_amdgcn_permlane32_swap(__float_as_uint(ps), __float_as_uint(ps), false, false);
      ps = __uint_as_float(rr[0]) + __uint_as_float(rr[1]); }
    l_reg = l_reg * alpha + ps;
#define PK4(P, BASE, OUT) do { unsigned a0 = cvt_pk_bf16(P[BASE + 0], P[BASE + 1]), a1 = cvt_pk_bf16(P[BASE + 2], P[BASE + 3]);   \
    unsigned b0 = cvt_pk_bf16(P[BASE + 4], P[BASE + 5]), b1 = cvt_pk_bf16(P[BASE + 6], P[BASE + 7]);                              \
    auto r0 = __builtin_amdgcn_permlane32_swap(a0, b0, false, false); auto r1 = __builtin_amdgcn_permlane32_swap(a1, b1, false, false); \
    u32x4 w = {r0[0], r1[0], r0[1], r1[1]}; OUT = __builtin_bit_cast(bf16x8, w); } while (0)
    PK4(F, 0, pa[0]); PK4(F, 8, pa[1]); PK4(S, (SB & 8), pa[2]);
#undef PK4
}
template <int D0, int KA, int KB, int KC> __device__ __forceinline__ void pv_three(f32x16& oa, int vb, const bf16x8 (&pa)[3]) {
    const s16x4 l0 = tr_read<v_rd_off(D0, KA, 0)>(vb), h0 = tr_read<v_rd_off(D0, KA, 1)>(vb), l1 = tr_read<v_rd_off(D0, KB, 0)>(vb), h1 = tr_read<v_rd_off(D0, KB, 1)>(vb);
    const s16x4 l2 = tr_read<v_rd_off(D0, KC, 0)>(vb), h2 = tr_read<v_rd_off(D0, KC, 1)>(vb);
    asm volatile("s_waitcnt lgkmcnt(0)" ::: "memory"); SBAR();
    oa = __builtin_amdgcn_mfma_f32_32x32x16_bf16(pa[0], PKV(l0, h0), oa, 0, 0, 0);
    oa = __builtin_amdgcn_mfma_f32_32x32x16_bf16(pa[1], PKV(l1, h1), oa, 0, 0, 0);
    oa = __builtin_amdgcn_mfma_f32_32x32x16_bf16(pa[2], PKV(l2, h2), oa, 0, 0, 0);
}
__device__ __forceinline__ void dma_offsets(int wid, int lane, unsigned (&ko)[2], unsigned (&vo)[2]) {
#pragma unroll
    for (int p = 0; p < 2; ++p) { const int pc = wid * 2 + p;
        { const int row = pc * 4 + (lane >> 4), ch = (lane & 15) ^ (row & 15); ko[p] = (unsigned)(row * NQKV + ch * 8) * 2u; }
        { const int s = pc * 64 + lane, st = s >> 5, wi = s & 31, kk = (st >> 2) * 8 + (wi >> 2), k = (kk & ~0xC) | ((kk & 4) << 1) | ((kk & 8) >> 1), c = (st & 3) * 32 + (wi & 3) * 8;
          vo[p] = (unsigned)(k * NQKV + c) * 2u; } }
}
__device__ __forceinline__ void dma_issue(const char* Kg, const char* Vg, const unsigned (&ko)[2], const unsigned (&vo)[2], LAS unsigned char* L, int kbuf, int vbuf, int wid) {
#pragma unroll
    for (int p = 0; p < 2; ++p) {
        __builtin_amdgcn_global_load_lds((const unsigned*)(Kg + ko[p]), (LAS unsigned*)(L + A_OFF_K + kbuf * 16384 + (wid * 2 + p) * 1024), 16, 0, 0);
        __builtin_amdgcn_global_load_lds((const unsigned*)(Vg + vo[p]), (LAS unsigned*)(L + A_OFF_V + vbuf * 16384 + (wid * 2 + p) * 1024), 16, 0, 0);
    }
}
#define TILE_SYNC() do { asm volatile("s_waitcnt vmcnt(0)" ::: "memory"); __syncthreads(); } while (0)
#define RESC1(o, nb, a) do { if (__any((a) < 1.f)) { if (hi == 0) al_l[r32] = (a); asm volatile("s_waitcnt lgkmcnt(0)" ::: "memory"); \
    _Pragma("unroll") for (int d_ = 0; d_ < nb; ++d_) _Pragma("unroll") for (int r_ = 0; r_ < 16; ++r_) o[d_][r_] *= al_l[crow(r_, hi)]; \
    asm volatile("s_waitcnt lgkmcnt(0)" ::: "memory"); } } while (0)

__device__ __forceinline__ void diff_unit(bf16_t* QKV, int row0, int T, int q0, int h, float lam, float oscale, const float* subg, LAS unsigned char* L, int wave_s) {
    const int tid = opaque_tid(wave_s), wid = __builtin_amdgcn_readfirstlane(tid >> 6), lane = tid & 63, r32 = lane & 31, hi = lane >> 5;
    LAS float* al_l = (LAS float*)(L + A_OFF_WS) + wid * 64; LAS float* li_l = al_l + 32;
    const int qrow0 = row0 + q0 + wid * 32;
    LAS unsigned char* Qs = L + A_OFF_Q + wid * 8704 + r32 * 272 + hi * 16;
    bf16x8 q1r[4];
    { const bf16_t* Qw = QKV + (size_t)(qrow0 + r32) * NQKV + C_QB + h * 128 + hi * 8;
#pragma unroll
      for (int d0 = 0; d0 < 4; ++d0) q1r[d0] = *(const bf16x8*)(Qw + d0 * 16);
#pragma unroll
      for (int d0 = 4; d0 < 8; ++d0) *(LAS bf16x8*)(Qs + d0 * 32) = *(const bf16x8*)(Qw + d0 * 16); }
    const char* Kg = (const char*)(QKV + (size_t)row0 * NQKV + C_KB + h * 128);
    const char* Vg = (const char*)(QKV + (size_t)row0 * NQKV + C_VB + h * 128);
    const int vb0 = (int)(unsigned)(uintptr_t)(L + A_OFF_V) + v_rd_base(lane);
    const size_t tstep = (size_t)64 * NQKV * 2;
    const int NT = T / 64;
    f32x16 o1[4] = {}, o2[4] = {};
    float m1 = -1e30f, m2 = -1e30f, l1 = 0.f, l2 = 0.f;
    const int trailing = wid >> 2;
    unsigned go[2];
    { unsigned ko4[2], vo4[2];
      dma_offsets((wid & 3) * 2, lane, ko4, vo4); go[0] = trailing ? vo4[0] : ko4[0]; go[1] = trailing ? vo4[1] : ko4[1]; }
    const unsigned go23 = (trailing ? 4u : 8u) * (unsigned)(NQKV * 2), gox = trailing ? 0u : 0x80u;
    const char* Gsrc = trailing ? Vg : Kg;
    const int gdst = (trailing ? A_OFF_V : A_OFF_K) + (wid & 3) * 4096;
#define DIFF_DMA(t) do { const char* gs_ = Gsrc + (size_t)(t) * tstep; const int gd_ = gdst + ((t) & 1) * 16384; \
        _Pragma("unroll") for (int p_ = 0; p_ < 4; ++p_) __builtin_amdgcn_global_load_lds((const unsigned*)(gs_ + ((p_ >> 1) ? (go[p_ & 1] ^ gox) + go23 : go[p_ & 1])), (LAS unsigned*)(L + gd_ + p_ * 1024), 16, 0, 0); } while (0)
    DIFF_DMA(0); TILE_SYNC();
    if (trailing) __builtin_amdgcn_s_barrier();
#pragma unroll 1
    for (int t = 0; t < NT; ++t) {
        bf16x8 pa[4], pb[4]; f32x16 p0, p1; float al1, al2;
        if (t + 1 < NT) DIFF_DMA(t + 1);
        { const LAS unsigned char* Ks = L + A_OFF_K + (t & 1) * 16384; bf16x8 qr[4];
          qkt4(p0, p1, Ks, q1r, 0, r32, hi);
          softmax_tile(p0, p1, m1, l1, al1, pa[0], pa[1], pa[2], pa[3]);
#pragma unroll
          for (int d0 = 0; d0 < 4; ++d0) qr[d0] = *(const LAS bf16x8*)(Qs + (d0 + 4) * 32);
          qkt4(p0, p1, Ks, qr, 4, r32, hi); }
        asm volatile("s_waitcnt lgkmcnt(0)" ::: "memory"); __builtin_amdgcn_s_barrier(); asm volatile("" ::: "memory");
        softmax_tile(p0, p1, m2, l2, al2, pb[0], pb[1], pb[2], pb[3]);
        RESC1(o1, 4, al1); RESC1(o2, 4, al2);
        { const int vb = vb0 + (t & 1) * 16384;
          pv_two<0>(o1[0], o2[0], vb, pa, pb); pv_two<1>(o1[1], o2[1], vb, pa, pb); pv_two<2>(o1[2], o2[2], vb, pa, pb); pv_two<3>(o1[3], o2[3], vb, pa, pb); }
        asm volatile("s_waitcnt vmcnt(0) lgkmcnt(0)" ::: "memory"); __builtin_amdgcn_s_barrier(); asm volatile("" ::: "memory");
    }
    if (!trailing) __builtin_amdgcn_s_barrier();
#undef DIFF_DMA
    if (hi == 0) { al_l[r32] = l1; li_l[r32] = l2; } asm volatile("s_waitcnt lgkmcnt(0)" ::: "memory");
    float gsc[4];
#pragma unroll
    for (int d0 = 0; d0 < 4; ++d0) gsc[d0] = subg[d0 * 32 + r32] * oscale;
    bf16_t* Ow = QKV + (size_t)qrow0 * NQKV + C_QB + h * 128 + r32;
#pragma unroll
    for (int r = 0; r < 16; ++r) {
        const int orow = crow(r, hi);
        const float r1 = __builtin_amdgcn_rcpf(al_l[orow]), r2 = lam * __builtin_amdgcn_rcpf(li_l[orow]);
        float v[4]; float ss = 0.f;
#pragma unroll
        for (int d0 = 0; d0 < 4; ++d0) { v[d0] = o1[d0][r] * r1 - o2[d0][r] * r2; ss += v[d0] * v[d0]; }
        ss += swz_xor<1>(ss); ss += swz_xor<2>(ss); ss += swz_xor<4>(ss); ss += swz_xor<8>(ss); ss += swz_xor<16>(ss);
        const float rn = __builtin_amdgcn_rsqf(ss * (1.0f / 128.0f) + EPS);
#pragma unroll
        for (int d0 = 0; d0 < 4; ++d0) { const float y = v[d0] * rn * gsc[d0]; Ow[(size_t)orow * NQKV + d0 * 32] = (bf16_t)(cvt_pk_bf16(y, y) & 0xffffu); }
    }
    asm volatile("s_waitcnt lgkmcnt(0)" ::: "memory");
}

__device__ __forceinline__ void na_unit(bf16_t* QKV, int row0, int R, int rp, int hp, const float* rpb, LAS unsigned char* L, int wave_s) {
    const int tid = opaque_tid(wave_s), wid = __builtin_amdgcn_readfirstlane(tid >> 6), lane = tid & 63, r32 = lane & 31, hi = lane >> 5;
    constexpr int N_OFF_WS = 98304, N_OFF_BIAS = 100352;
    LAS float* al_l = (LAS float*)(L + N_OFF_WS) + wid * 64; LAS float* li_l = al_l + 32;
    LAS float* bias = (LAS float*)(L + N_OFF_BIAS);
    for (int i = tid; i < 2 * 15 * 31; i += 512) bias[i] = rpb[hp * 2 * 15 * 31 + i] * LOG2E;
    const int qrow = wid >> 2, head = (wid >> 1) & 1, half = wid & 1, hh = hp * 2 + head;
    const int r = 2 * rp + qrow;
    const int st = min(max(r - 4, 0), R - 8);
    const int kr_lo = min(max(2 * rp - 4, 0), R - 8), kr_hi = min(max(2 * rp + 1 - 4, 0), R - 8) + 7;
    const int tok0 = row0 + r * 64 + half * 32;
    bf16x8 qr[4];
    { const bf16_t* Qw = QKV + (size_t)(tok0 + r32) * NQKV + C_QA + hh * 64 + hi * 8;
#pragma unroll
      for (int d0 = 0; d0 < 4; ++d0) qr[d0] = *(const bf16x8*)(Qw + d0 * 16); }
    const char* Kg = (const char*)(QKV + (size_t)row0 * NQKV + C_KA + hp * 128);
    const char* Vg = (const char*)(QKV + (size_t)row0 * NQKV + C_VA + hp * 128);
    unsigned ko[2], vo[2]; dma_offsets(wid, lane, ko, vo);
    const int vb0 = (int)(unsigned)(uintptr_t)(L + A_OFF_V) + v_rd_base(lane);
    const size_t tstep = (size_t)64 * NQKV * 2;
    const int c = half * 32 + r32, cs = min(max(c - 8, 0), 48);
    f32x16 o[2] = {};
    float m_reg = -1e30f, l_reg = 0.f;
    dma_issue(Kg + (size_t)kr_lo * tstep, Vg + (size_t)kr_lo * tstep, ko, vo, L, 0, 0, wid);
    dma_issue(Kg + (size_t)(kr_lo + 1) * tstep, Vg + (size_t)(kr_lo + 1) * tstep, ko, vo, L, 1, 1, wid);
    asm volatile("s_waitcnt vmcnt(4) lgkmcnt(0)" ::: "memory"); __builtin_amdgcn_s_barrier(); asm volatile("" ::: "memory");
    int cur = 0, nx2 = 2;
#pragma unroll 1
    for (int kr = kr_lo; kr <= kr_hi; ++kr) {
        if (kr + 2 <= kr_hi) dma_issue(Kg + (size_t)(kr + 2) * tstep, Vg + (size_t)(kr + 2) * tstep, ko, vo, L, nx2, nx2, wid);
        if (kr >= st && kr < st + 8) {
            const LAS unsigned char* Ks = L + A_OFF_K + cur * 16384;
            f32x16 p0, p1; bf16x8 pa[3]; float al;
            qkt4(p0, p1, Ks, qr, head * 4, r32, hi);
            const int dr = kr - r + 7;
            const LAS float* bl = bias + (head * 15 + dr) * 31 + (4 * hi - c + 15);
            const int relb = 4 * hi - cs;
            const int vb = vb0 + cur * 16384;
            if (half == 0) {
                na_tile<0>(p0, p1, bl, relb, m_reg, l_reg, al, pa);
                RESC1(o, 2, al);
                if (head == 0) { pv_three<0, 0, 1, 2>(o[0], vb, pa); pv_three<1, 0, 1, 2>(o[1], vb, pa); } else { pv_three<2, 0, 1, 2>(o[0], vb, pa); pv_three<3, 0, 1, 2>(o[1], vb, pa); }
            } else {
                na_tile<1>(p0, p1, bl, relb, m_reg, l_reg, al, pa);
                RESC1(o, 2, al);
                if (head == 0) { pv_three<0, 2, 3, 1>(o[0], vb, pa); pv_three<1, 2, 3, 1>(o[1], vb, pa); } else { pv_three<2, 2, 3, 1>(o[0], vb, pa); pv_three<3, 2, 3, 1>(o[1], vb, pa); }
            }
        }
        if (kr + 2 <= kr_hi) asm volatile("s_waitcnt vmcnt(4) lgkmcnt(0)" ::: "memory"); else asm volatile("s_waitcnt vmcnt(0) lgkmcnt(0)" ::: "memory");
        __builtin_amdgcn_s_barrier(); asm volatile("" ::: "memory");
        cur = (cur == 2) ? 0 : cur + 1; nx2 = (nx2 == 2) ? 0 : nx2 + 1;
    }
    if (hi == 0) li_l[r32] = l_reg; asm volatile("s_waitcnt lgkmcnt(0)" ::: "memory");
    bf16_t* Ow = QKV + (size_t)tok0 * NQKV + C_QA + hh * 64 + r32;
#pragma unroll
    for (int rr = 0; rr < 16; ++rr) { const int orow = crow(rr, hi); const float rl = __builtin_amdgcn_rcpf(li_l[orow]);
#pragma unroll
        for (int d0 = 0; d0 < 2; ++d0) { const float y = o[d0][rr] * rl; Ow[(size_t)orow * NQKV + d0 * 32] = (bf16_t)(cvt_pk_bf16(y, y) & 0xffffu); } }
    asm volatile("s_waitcnt lgkmcnt(0)" ::: "memory");
}
}

#define XB_TMO      128
#define XB_XCNT(j)  (256  + 64 * (j))
#define XB_XSUB(j)  (1280 + 64 * (j))
#define XB_XGEN(j)  (2304 + 64 * (j))
#define XB_TOP      3328
#define XB_TOPGEN   3392
#define XB_SPIN_CAP (1u << 22)
__device__ __forceinline__ unsigned xb_ld(unsigned* p)              { return __hip_atomic_load(p, __ATOMIC_RELAXED, __HIP_MEMORY_SCOPE_AGENT); }
__device__ __forceinline__ unsigned xb_add(unsigned* p, unsigned v) { return __hip_atomic_fetch_add(p, v, __ATOMIC_RELAXED, __HIP_MEMORY_SCOPE_AGENT); }
__device__ __forceinline__ unsigned xb_xcc_id() { return (unsigned)__builtin_amdgcn_s_getreg((3 << 11) | 20) & 0xFu; }
#define XB_SPIN(cond, bar) do { unsigned _sp = 0; while (cond) { __builtin_amdgcn_s_sleep(1); \
    if ((++_sp & 255u) == 0u) { if (xb_ld(&(bar)[XB_TMO])) break; if (_sp > XB_SPIN_CAP) { atomicAdd(&(bar)[XB_TMO], 1u); break; } } } } while (0)
__device__ __forceinline__ void xcd_barrier_complete(unsigned* bar, unsigned x, unsigned& nloc, unsigned& nx) {
    const unsigned G = gridDim.x * gridDim.y * gridDim.z;
    unsigned sum, cnt, mine, sp = 0u;
    for (;;) {
        sum = 0u; cnt = 0u; mine = 0u;
#pragma unroll
        for (unsigned j = 0; j < 16; ++j) { const unsigned c = xb_ld(&bar[XB_XCNT(j)]); sum += c; cnt += (c > 0u) ? 1u : 0u; mine = (j == x) ? c : mine; }
        if (sum == G) break;
        __builtin_amdgcn_s_sleep(1);
        if ((++sp & 255u) == 0u) { if (xb_ld(&bar[XB_TMO])) break; if (sp > XB_SPIN_CAP) { atomicAdd(&bar[XB_TMO], 1u); break; } }
    }
    nloc = mine > 0u ? mine : 1u; nx = cnt > 0u ? cnt : 1u;
}
__device__ __forceinline__ void xcd_barrier(unsigned* bar, unsigned nloc, unsigned nx, unsigned k, int wave_s) {
    asm volatile("s_waitcnt vmcnt(0)" ::: "memory");
    __syncthreads();
    if (opaque_tid(wave_s) == 0) {
        const unsigned x = xb_xcc_id();
        __builtin_amdgcn_s_waitcnt(0);
        const unsigned old = xb_add(&bar[XB_XSUB(x)], 1u);
        const unsigned gen = k;
        if (old + 1u == (gen + 1u) * nloc) {
            __builtin_amdgcn_fence(__ATOMIC_RELEASE, "agent");
            asm volatile("s_waitcnt vmcnt(0)" ::: "memory");
            const unsigned og = xb_add(&bar[XB_TOP], 1u);
            const unsigned tg = k;
            if (og + 1u == (tg + 1u) * nx) xb_add(&bar[XB_TOPGEN], 1u);
            else XB_SPIN(xb_ld(&bar[XB_TOPGEN]) == tg, bar);
            __builtin_amdgcn_fence(__ATOMIC_ACQUIRE, "agent");
            xb_add(&bar[XB_XGEN(x)], 1u);
            asm volatile("s_waitcnt vmcnt(0)" ::: "memory");
        } else {
            XB_SPIN(xb_ld(&bar[XB_XGEN(x)]) == gen, bar);
            __builtin_amdgcn_fence(__ATOMIC_ACQUIRE, "agent");
            asm volatile("s_waitcnt vmcnt(0)" ::: "memory");
        }
    }
    __syncthreads();
}

struct Args {
    const float* in[17];
    float* out; unsigned char* ws;
};

typedef __attribute__((address_space(4))) const char* karg_t;
__device__ __forceinline__ karg_t kargs() { karg_t p = (karg_t)__builtin_amdgcn_kernarg_segment_ptr(); asm volatile("" : "+s"(p)); return p; }
__device__ __forceinline__ const float* arg_in(int i) { return *(const float* const __attribute__((address_space(4)))*)(kargs() + 8 * i); }
__device__ __forceinline__ float* arg_out() { return *(float* const __attribute__((address_space(4)))*)(kargs() + 8 * 17); }
__device__ __forceinline__ unsigned char* arg_ws() { return *(unsigned char* const __attribute__((address_space(4)))*)(kargs() + 8 * 18); }
template <int MODE>
__device__ __forceinline__ int colmap(int n) {
    if (MODE == 1) {
        if (n < 512) return n;
        if (n < 1024) { const int j = n - 512, blk = j >> 6, p = j & 63; return 1536 + blk * 64 + (p >> 1) + 32 * (p & 1); }
        if (n < 1536) return 512 + (n - 1024);
        if (n < 2048) return 1024 + (n - 1536);
        if (n < 2560) { const int j = n - 2048, blk = j >> 6, p = j & 63; return 2048 + blk * 64 + (p >> 1) + 32 * (p & 1); }
        return n;
    }
    if (MODE == 2) { const int pn = n >> 8, bj = (n >> 7) & 1, j = n & 127; return bj * DFF + pn * 128 + j; }
    return n;
}
template <int MODE>
__device__ __forceinline__ void conv_mat(const float* src, int K, int N, bf16_t* dst, const float* scale, int gtid, int gthreads) {
    const int kch = K / 64; const long items = (long)N * kch;
    for (long it = gtid; it < items; it += gthreads) {
        const int n = (int)(it % N), k0 = (int)(it / N) * 64; const int sc = colmap<MODE>(n);
#pragma unroll
        for (int h = 0; h < 2; ++h) {
            float v[32];
#pragma unroll
            for (int j = 0; j < 32; ++j) v[j] = src[(size_t)(k0 + h * 32 + j) * N + sc];
            if (scale) {
#pragma unroll
                for (int j = 0; j < 32; ++j) v[j] *= scale[k0 + h * 32 + j];
            }
#pragma unroll
            for (int q = 0; q < 4; ++q) { u32x4 w; w.x = cvt_pk_bf16(v[8 * q], v[8 * q + 1]); w.y = cvt_pk_bf16(v[8 * q + 2], v[8 * q + 3]); w.z = cvt_pk_bf16(v[8 * q + 4], v[8 * q + 5]); w.w = cvt_pk_bf16(v[8 * q + 6], v[8 * q + 7]);
                *(u32x4*)(dst + (size_t)n * K + k0 + h * 32 + 8 * q) = w; }
        }
    }
}
__device__ __forceinline__ void convert_layer(int l, unsigned char* wb, int gtid, int gthreads) {
    conv_mat<1>(arg_in(3) + (size_t)l * DM * NQKV, DM, NQKV, (bf16_t*)(wb + W_IN), arg_in(2) + (size_t)l * DM, gtid, gthreads);
    conv_mat<0>(arg_in(10) + (size_t)l * DM * DM, DM, DM, (bf16_t*)(wb + W_OUT), nullptr, gtid, gthreads);
    conv_mat<2>(arg_in(12) + (size_t)l * DM * NUP, DM, NUP, (bf16_t*)(wb + W_UP), arg_in(11) + (size_t)l * DM, gtid, gthreads);
    conv_mat<0>(arg_in(15) + (size_t)l * DFF * DM, DFF, DM, (bf16_t*)(wb + W_DOWN), nullptr, gtid, gthreads);
}

__global__ void __launch_bounds__(512, 2) mega_fwd(Args a) {
    extern __shared__ __attribute__((aligned(16))) unsigned char lds_raw[];
    LAS unsigned char* L = (LAS unsigned char*)lds_raw;
    cg::grid_group grid = cg::this_grid();
    const int G = gridDim.x, bx = blockIdx.x;
    const int wave_s = __builtin_amdgcn_readfirstlane((int)(threadIdx.x >> 6));
    { unsigned* barp = (unsigned*)(arg_ws() + WS_CTL); if (threadIdx.x == 0) (void)xb_add(&barp[XB_XCNT(xb_xcc_id())], 1u); }
    unsigned bar_nloc = 1u, bar_nx = 1u;
#define GRID_BAR(j) xcd_barrier((unsigned*)(arg_ws() + WS_CTL), bar_nloc, bar_nx, (unsigned)(1 + l * 6 + (j)), wave_s)
#define FRAME_IDS() const int tid = opaque_tid(wave_s), lane = tid & 63, wave = wave_s; \
    const int gtid = bx * 512 + tid, gthreads = G * 512, gw = bx * 8 + wave, NGW = G * 8; (void)lane; (void)gtid; (void)gthreads; (void)gw; (void)NGW
#define PTRS() unsigned char* ws = arg_ws(); bf16_t* QKV = (bf16_t*)(ws + WS_QKV); bf16_t* Hb = (bf16_t*)(ws + WS_QKV); bf16_t* XB = (bf16_t*)(ws + WS_XB); \
    float* HB = (float*)(ws + WS_HB); float* SSQ = (float*)(ws + WS_SSQ); f32x2* ROPE = (f32x2*)(ws + WS_ROPE); float* X = arg_out(); \
    (void)QKV; (void)Hb; (void)XB; (void)HB; (void)SSQ; (void)ROPE; (void)X

    {
    FRAME_IDS(); PTRS();
    for (int m = gw; m < M_TOK; m += NGW) {
        const float* src = (m < M_PROMPT) ? arg_in(0) + (size_t)m * DM : arg_in(1) + (size_t)(m - M_PROMPT) * DM;
        float s = 0.f;
#pragma unroll
        for (int j = 0; j < 4; ++j) { const f32x4 v = *(const f32x4*)(src + j * 256 + lane * 4);
            u32x2 w; w.x = cvt_pk_bf16(v[0], v[1]); w.y = cvt_pk_bf16(v[2], v[3]); *(u32x2*)(XB + (size_t)m * DM + j * 256 + lane * 4) = w;
            const float r0 = __uint_as_float(w.x << 16), r1 = __uint_as_float(w.x & 0xffff0000u), r2 = __uint_as_float(w.y << 16), r3 = __uint_as_float(w.y & 0xffff0000u);
            s += (r0 * r0 + r1 * r1) + (r2 * r2 + r3 * r3); }
#pragma unroll
        for (int o = 1; o < 64; o <<= 1) s += __shfl_xor(s, o);
        if (lane < 16) SSQ[(size_t)m * 16 + lane] = (lane == 0) ? s : 0.f;
    }
    for (int i = gtid; i < 8192 * 32; i += gthreads) {
        const int t = i >> 5, fi = i & 31;
        const float invf = 1.0f / exp2f((float)fi * (13.287712379549449f / 32.0f));
        const float ang = (float)t * invf;
        double rev = (double)ang * 0.15915494309189535; rev -= floor(rev);
        const float fr = (float)rev;
        ROPE[i] = (f32x2){__builtin_amdgcn_cosf(fr), __builtin_amdgcn_sinf(fr)};
    }
    conv_mat<1>(arg_in(3), DM, NQKV, (bf16_t*)(ws + WS_W + W_IN), arg_in(2), gtid, gthreads);
    }
    if (gridDim.x == 0x7fffffffu) grid.sync();
    { unsigned* barp = (unsigned*)(arg_ws() + WS_CTL); unsigned nl, nx_; xcd_barrier_complete(barp, xb_xcc_id(), nl, nx_);
      bar_nloc = (unsigned)__builtin_amdgcn_readfirstlane((int)nl); bar_nx = (unsigned)__builtin_amdgcn_readfirstlane((int)nx_); }
    xcd_barrier((unsigned*)(arg_ws() + WS_CTL), bar_nloc, bar_nx, 0u, wave_s);

#define CONV_Q(ln_, cidx_, lo_, hi_) do { \
        unsigned char* ws_ = arg_ws(); unsigned* cctr = (unsigned*)(ws_ + WS_CTL) + 4048 + (cidx_); \
        unsigned char* wbn = ws_ + WS_W + (size_t)((ln_) & 1) * W_LAYER; const int ln = (ln_); \
        volatile LAS int* cslot = (volatile LAS int*)(L + LDS_BYTES - 16); \
        for (;;) { \
            __syncthreads(); \
            if (opaque_tid(wave_s) == 0) *cslot = (int)__hip_atomic_fetch_add(cctr, 1u, __ATOMIC_RELAXED, __HIP_MEMORY_SCOPE_AGENT); \
            __syncthreads(); \
            const int cb = (lo_) + __builtin_amdgcn_readfirstlane(*cslot); \
            if (cb >= (hi_)) break; \
            const int t = opaque_tid(wave_s); \
            if (cb < 96) conv_mat<1>(arg_in(3) + (size_t)ln * DM * NQKV, DM, NQKV, (bf16_t*)(wbn + W_IN), arg_in(2) + (size_t)ln * DM, cb * 512 + t, 1 << 30); \
            else if (cb < 128) conv_mat<0>(arg_in(10) + (size_t)ln * DM * DM, DM, DM, (bf16_t*)(wbn + W_OUT), nullptr, (cb - 96) * 512 + t, 1 << 30); \
            else if (cb < 304) conv_mat<2>(arg_in(12) + (size_t)ln * DM * NUP, DM, NUP, (bf16_t*)(wbn + W_UP), arg_in(11) + (size_t)ln * DM, (cb - 128) * 512 + t, 1 << 30); \
            else conv_mat<0>(arg_in(15) + (size_t)ln * DFF * DM, DFF, DM, (bf16_t*)(wbn + W_DOWN), nullptr, (cb - 304) * 512 + t, 1 << 30); \
        } } while (0)
#pragma unroll 1
    for (int l = 0; l < DEPTH; ++l) {
#define LPTRS() PTRS(); unsigned char* wb = ws + WS_W + (size_t)(l & 1) * W_LAYER; \
        const float* ssqA = SSQ + (size_t)(2 * l) * SSQ_STAGE; float* ssqB = SSQ + (size_t)(2 * l + 1) * SSQ_STAGE; float* ssqC = SSQ + (size_t)(2 * l + 2) * SSQ_STAGE; (void)wb; (void)ssqA; (void)ssqB; (void)ssqC
        { LPTRS(); pg8::Gemm g{XB, (const bf16_t*)(wb + W_IN), M_TOK, NQKV, DM, DM}; pg8::StaticOrder S; S.init(M_TOK, NQKV, G, bx);
          EpiInProj E{QKV, ssqA, ROPE}; pg8::gemm_phase<EpiInProj>(L, g, S, E, wave_s); }
        if (l == 0) CONV_Q(0, 4, 96, 392);
        GRID_BAR(0);
        {
            FRAME_IDS(); PTRS();
            const float* rpb = arg_in(4) + (size_t)l * 8 * 15 * 31;
            const float lam_init = 0.8f - 0.6f * expf(-0.3f * (float)l);
            float d1 = 0.f, d2 = 0.f;
            for (int i = 0; i < 64; ++i) { d1 += arg_in(5)[l * 64 + i] * arg_in(6)[l * 64 + i]; d2 += arg_in(7)[l * 64 + i] * arg_in(8)[l * 64 + i]; }
            const float lam = expf(d1) - expf(d2) + lam_init;
            const float* subg = arg_in(9) + (size_t)l * 128;
            __syncthreads();
            for (int u = opaque_s(bx); u < 512; u += G) {
                if (u < 256) {
                    const int x = u & 7, j = u >> 3; const int b = x >> 2, h = x & 3;
                    att::diff_unit(QKV, M_PROMPT + b * T_S, T_S, j * 256, h, lam, 1.0f - lam_init, subg, L, wave_s);
                } else {
                    const int v = u - 256, x = v & 7, j = v >> 3; const int bh = 2 * x + (j >> 4), b = bh >> 2, h = bh & 3;
                    att::diff_unit(QKV, b * T_P, T_P, (j & 15) * 256, h, lam, 1.0f - lam_init, subg, L, wave_s);
                }
            }
            {
                const bool xq = (G == 256);
                const int x0 = xq ? (bx & 7) : 0, qlen = xq ? 128 : 1024, nq = xq ? 8 : 1;
                unsigned* ctr0 = (unsigned*)(ws + WS_CTL) + 3520 + l * 128;
                volatile LAS int* slot = (volatile LAS int*)(L + 116736);
                int qi = 0;
                for (;;) {
                    const int x = (x0 + qi) & 7;
                    __syncthreads();
                    if (opaque_tid(wave_s) == 0) *slot = (int)__hip_atomic_fetch_add(ctr0 + x * 16, 1u, __ATOMIC_RELAXED, __HIP_MEMORY_SCOPE_AGENT);
                    __syncthreads();
                    const int n = __builtin_amdgcn_readfirstlane(*slot);
                    if (n >= qlen) { if (++qi >= nq) break; continue; }
                    int rpg = n >> 2, hp = n & 3;
                    if (xq) { const int kk = n >> 5, i = n & 31; rpg = (kk * 8 + x) * 8 + (i >> 2); hp = i & 3; }
                    const int sq = rpg < 128 ? 0 : 1, q = rpg - 128 * sq, b = sq ? (q >> 6) : (q >> 5);
                    att::na_unit(QKV, sq ? M_PROMPT + b * T_S : b * T_P, sq ? 128 : 64, sq ? (q & 63) : (q & 31), hp, rpb, L, wave_s);
                }
            }
        }
        GRID_BAR(1);
        { LPTRS(); pg8::Gemm g{QKV, (const bf16_t*)(wb + W_OUT), M_TOK, DM, DM, NQKV}; pg8::StaticOrder S; S.init(M_TOK, DM, G, bx);
          EpiResid E{XB, ssqB}; pg8::gemm_phase<EpiResid>(L, g, S, E, wave_s); }
        if (l + 1 < DEPTH) CONV_Q(l + 1, 8 + l * 4 + 0, 0, 130);
        GRID_BAR(2);
        { LPTRS(); pg8::Gemm g{XB, (const bf16_t*)(wb + W_UP), M_TOK, NUP, DM, DM}; pg8::StaticOrder S; S.init(M_TOK, NUP, G, bx);
          EpiUp E{Hb, HB, ssqB, arg_in(13) + (size_t)l * 3 * DFF, arg_in(14) + (size_t)l * DFF}; pg8::gemm_phase<EpiUp>(L, g, S, E, wave_s); }
        if (l + 1 < DEPTH) CONV_Q(l + 1, 8 + l * 4 + 1, 130, 260);
        GRID_BAR(3);
        {
            FRAME_IDS(); PTRS();
            const float* cw = arg_in(13) + (size_t)l * 3 * DFF;
            for (int i = gtid; i < 1024 * (DFF / 4); i += gthreads) {
                const int bi = i / (DFF / 4), cq = (i % (DFF / 4)) * 4, grp = bi >> 1, which = bi & 1;
                const int row = grp * 64 + (which ? 63 : 0);
                const float* hb = HB + (size_t)(bi * 3) * DFF + cq;
                f32x4 x = *(const f32x4*)hb; const f32x4 v = *(const f32x4*)(hb + DFF);
                const int nrow = which ? row + 1 : row;
                const bool seq_start = (nrow < M_PROMPT) ? ((nrow & (T_P - 1)) == 0) : ((nrow & (T_S - 1)) == 0);
                if (!seq_start) {
                    const int nbi = which ? (grp + 1) * 2 : (grp - 1) * 2 + 1;
                    const f32x4 nb = *(const f32x4*)(HB + (size_t)(nbi * 3 + 2) * DFF + cq);
                    const f32x4 w = *(const f32x4*)(cw + (which ? 2 * DFF : 0) + cq);
                    x += w * nb;
                }
                const f32x4 hval = gelu4(x) * v;
                u32x2 w2; w2.x = cvt_pk_bf16(hval[0], hval[1]); w2.y = cvt_pk_bf16(hval[2], hval[3]);
                *(u32x2*)(Hb + (size_t)row * DFF + cq) = w2;
            }
        }
        GRID_BAR(4);
        { LPTRS(); pg8::Gemm g{Hb, (const bf16_t*)(wb + W_DOWN), M_TOK, DM, DFF, DFF}; pg8::StaticOrder S; S.init(M_TOK, DM, G, bx);
          EpiResid E{XB, ssqC}; pg8::gemm_phase<EpiResid>(L, g, S, E, wave_s); }
        if (l + 1 < DEPTH) CONV_Q(l + 1, 8 + l * 4 + 2, 260, 392);
        GRID_BAR(5);
    }
    {
        FRAME_IDS(); PTRS();
        const float* ssqF = SSQ + (size_t)8 * SSQ_STAGE; const float* gf = arg_in(16);
        for (int m = gw; m < M_TOK; m += NGW) {
            const float rs = rstd_row(ssqF, m);
#pragma unroll
            for (int j = 0; j < 4; ++j) { const u32x2 w = *(const u32x2*)(XB + (size_t)m * DM + j * 256 + lane * 4); const f32x4 gg = *(const f32x4*)(gf + j * 256 + lane * 4);
                const f32x4 v = {__uint_as_float(w.x << 16), __uint_as_float(w.x & 0xffff0000u), __uint_as_float(w.y << 16), __uint_as_float(w.y & 0xffff0000u)};
                *(f32x4*)(X + (size_t)m * DM + j * 256 + lane * 4) = v * rs * gg; }
        }
    }
}

extern "C" void kernel_launch(void* const* d_in, const int* in_sizes, int n_in, void* d_out, int out_size, void* d_ws, size_t ws_size, hipStream_t stream) {
    static int grid_blocks = 0;
    if (grid_blocks == 0) {
        if (n_in != 17 || out_size != M_TOK * DM || ws_size < WS_END) { fprintf(stderr, "kernel_launch: unexpected shapes / workspace (n_in %d out %d ws %zu need %zu)\n", n_in, out_size, ws_size, (size_t)WS_END); grid_blocks = -1; return; }
        int dev = 0, cus = 0, per_cu = 0;
        hipGetDevice(&dev);
        hipDeviceGetAttribute(&cus, hipDeviceAttributeMultiprocessorCount, dev);
        if (hipFuncSetAttribute((const void*)mega_fwd, hipFuncAttributeMaxDynamicSharedMemorySize, LDS_BYTES) != hipSuccess) { fprintf(stderr, "kernel_launch: hipFuncSetAttribute failed\n"); grid_blocks = -1; return; }
        if (hipOccupancyMaxActiveBlocksPerMultiprocessor(&per_cu, (const void*)mega_fwd, 512, LDS_BYTES) != hipSuccess || per_cu < 1) per_cu = 1;
        (void)hipGetLastError();
        grid_blocks = cus * per_cu;
    }
    if (grid_blocks < 0) return;
    if (hipMemsetAsync((char*)d_ws + WS_CTL, 0, CTL_BYTES, stream) != hipSuccess) { fprintf(stderr, "kernel_launch: memset of the barrier words failed\n"); return; }
    Args a{};
    for (int i = 0; i < 17; ++i) a.in[i] = (const float*)d_in[i];
    a.out = (float*)d_out; a.ws = (unsigned char*)d_ws;
    void* args[] = {&a};
    hipError_t e = hipLaunchCooperativeKernel((const void*)mega_fwd, dim3(grid_blocks), dim3(512), args, LDS_BYTES, stream);
    if (e != hipSuccess) fprintf(stderr, "cooperative launch failed: %s (grid %d)\n", hipGetErrorString(e), grid_blocks);
}
```

```cpp
#include <hip/hip_runtime.h>
#include <hip/hip_cooperative_groups.h>
#include <cstdio>
#include <cstdint>
namespace cg = cooperative_groups;

#define LAS __attribute__((address_space(3)))
typedef unsigned short bf16_t;
typedef short bf16x8 __attribute__((ext_vector_type(8)));
typedef short s16x4 __attribute__((ext_vector_type(4)));
typedef float f32x4 __attribute__((ext_vector_type(4)));
typedef float f32x2 __attribute__((ext_vector_type(2)));
typedef float f32x16 __attribute__((ext_vector_type(16)));
typedef unsigned u32x4 __attribute__((ext_vector_type(4)));
typedef unsigned u32x2 __attribute__((ext_vector_type(2)));

constexpr int M_TOK = 32768, M_PROMPT = 16384, T_P = 4096, T_S = 8192;
constexpr int DM = 1024, NQKV = 3072, DFF = 2816, NUP = 5632, DEPTH = 4;
constexpr float EPS = 1e-6f;
constexpr float LOG2E = 1.4426950408889634f;
constexpr float QSCALE = 0.125f * LOG2E;
constexpr int C_QA = 0, C_QB = 512, C_KA = 1024, C_VA = 1536, C_KB = 2048, C_VB = 2560;

constexpr size_t MiB = 1u << 20;
constexpr size_t WS_QKV = 0;
constexpr size_t WS_XB = 192 * MiB;
constexpr size_t WS_W = 256 * MiB;
constexpr size_t W_IN = 0, W_OUT = (size_t)NQKV * DM * 2, W_UP = W_OUT + (size_t)DM * DM * 2, W_DOWN = W_UP + (size_t)NUP * DM * 2;
constexpr size_t W_LAYER = W_DOWN + (size_t)DM * DFF * 2;
constexpr size_t WS_HB = WS_W + 2 * W_LAYER;
constexpr size_t HB_BYTES = (size_t)1024 * 3 * DFF * 4;
constexpr size_t WS_SSQ = WS_HB + HB_BYTES;
constexpr size_t SSQ_STAGE = (size_t)M_TOK * 16;
constexpr size_t WS_ROPE = WS_SSQ + (size_t)9 * SSQ_STAGE * 4;
constexpr size_t WS_CTL = WS_ROPE + (size_t)8192 * 32 * 8;
constexpr size_t CTL_BYTES = 16384;
constexpr size_t WS_END = WS_CTL + CTL_BYTES;

constexpr int LDS_BYTES = 163840;
constexpr int A_OFF_V = 0  , A_OFF_K = 49152  , A_OFF_WS = 81920, A_OFF_Q = 83968, A_OFF_BIAS = 83968  ;

__device__ __forceinline__ unsigned cvt_pk_bf16(float lo, float hi) { unsigned r; asm volatile("v_cvt_pk_bf16_f32 %0, %1, %2" : "=v"(r) : "v"(lo), "v"(hi)); return r; }
__device__ __forceinline__ int opaque_tid(int wave_s) { int ln; asm volatile("v_mbcnt_lo_u32_b32 %0, -1, 0\n\tv_mbcnt_hi_u32_b32 %0, -1, %0" : "=v"(ln)); return wave_s * 64 + ln; }
__device__ __forceinline__ int opaque_s(int v) { asm volatile("" : "+s"(v)); return v; }
template <int XOR> __device__ __forceinline__ float swz_xor(float v) { return __int_as_float(__builtin_amdgcn_ds_swizzle(__float_as_int(v), (XOR << 10) | 0x1f)); }
__device__ __forceinline__ float rstd_of(float ssq) { return __builtin_amdgcn_rsqf(ssq * (1.0f / DM) + EPS); }
__device__ __forceinline__ float rstd_row(const float* ssqp, int row) {
    const f32x4* p = (const f32x4*)(ssqp + (size_t)row * 16); const f32x4 a = p[0], b = p[1], c = p[2], d = p[3];
    const float s = (((a[0] + a[1]) + (a[2] + a[3])) + ((b[0] + b[1]) + (b[2] + b[3]))) + (((c[0] + c[1]) + (c[2] + c[3])) + ((d[0] + d[1]) + (d[2] + d[3])));
    return rstd_of(s);
}
__device__ __forceinline__ float rstd_lds(const LAS float* st, int r) {
    const LAS f32x4* p = (const LAS f32x4*)(st + r * 16); const f32x4 a = p[0], b = p[1], c = p[2], d = p[3];
    const float s = (((a[0] + a[1]) + (a[2] + a[3])) + ((b[0] + b[1]) + (b[2] + b[3]))) + (((c[0] + c[1]) + (c[2] + c[3])) + ((d[0] + d[1]) + (d[2] + d[3])));
    return rstd_of(s);
}
__device__ __forceinline__ int tok_pos(int row) { return row < M_PROMPT ? (row & (T_P - 1)) : (row & (T_S - 1)); }

__device__ __forceinline__ f32x2 gelu_pk(f32x2 v) {
    const f32x2 av = __builtin_elementwise_abs(v), d = av * 0.2316418882f + 1.0f;
    f32x2 t; t.x = __builtin_amdgcn_rcpf(d.x); t.y = __builtin_amdgcn_rcpf(d.y);
    f32x2 q = t * 0.5307027145f + (-0.7265760135f); q = q * t + 0.7107068705f; q = q * t + (-0.142248368f); q = q * t + 0.127414796f; q = q * t;
    const f32x2 s = (v * v) * (-0.72134752044f);
    f32x2 e; e.x = __builtin_amdgcn_exp2f(s.x); e.y = __builtin_amdgcn_exp2f(s.y);
    const f32x2 m = v * (q * e), r = v - m;
    f32x2 o; o.x = v.x < 0.f ? m.x : r.x; o.y = v.y < 0.f ? m.y : r.y; return o;
}
__device__ __forceinline__ f32x4 gelu4(f32x4 v) { f32x2 a = gelu_pk((f32x2){v[0], v[1]}), b = gelu_pk((f32x2){v[2], v[3]}); return (f32x4){a.x, a.y, b.x, b.y}; }

namespace pg8 {
constexpr int BM = 256, BK = 64, HALF = 128, HTB = HALF * BK * 2, STAGE_BYTES = 8 * HTB, NXCD = 8, WGM = 8;
__host__ __device__ __forceinline__ int lds_byte(int r, int c) { const int st = (r >> 4) * 2 + (c >> 5), rr = r & 15, cc = c & 31, ob = rr * 64 + cc * 2; return st * 1024 + (ob ^ (((ob >> 9) & 1) << 5)); }
__host__ __device__ __forceinline__ void stage_rc(int b, int& R, int& C) { const int st = b / 1024, sb = b % 1024, swz = sb ^ (((sb >> 9) & 1) << 5); R = (st >> 1) * 16 + swz / 64; C = (st & 1) * 32 + (swz % 64) / 2; }
__host__ __device__ __forceinline__ int perm32(int rho) { const int n = rho >> 4, i = rho & 15; return 8 * (i >> 2) + 4 * n + (i & 3); }
struct Unit { int pm, pn; };
struct Gemm { const bf16_t* A; const bf16_t* Bt; int M, N, K, lda; };
struct StaticOrder {
    int nM, nN, nwg, G, c;
    __device__ void init(int M, int N, int G_, int c_) { nM = M / BM; nN = N / BM; nwg = nM * nN; G = G_; c = c_; }
    __device__ bool next(int i, Unit& u) const {
        const long L = (long)i * G + c; if (L >= nwg) return false;
        int wgid = (int)L; { const int q = nwg / NXCD, r = nwg % NXCD, xcd = wgid % NXCD, off = wgid / NXCD; wgid = (xcd < r ? xcd * (q + 1) : r * (q + 1) + (xcd - r) * q) + off; }
        const int nig = WGM * nN, gid = wgid / nig, fm = gid * WGM, gsz = (nM - fm) < WGM ? (nM - fm) : WGM;
        u.pm = fm + ((wgid % nig) % gsz); u.pn = (wgid % nig) / gsz; return true;
    }
};
template <class Epi>
__device__ __forceinline__ void gemm_phase(LAS unsigned char* lds, const Gemm g, const StaticOrder& S, const Epi& E, int wave_s) {
    const int tid = opaque_tid(wave_s), wid = __builtin_amdgcn_readfirstlane(tid >> 6), lane = tid & 63, wr = wid >> 2, wc = wid & 3, fr = lane & 15, fq = lane >> 4;
    const int K = g.K, nt = K / BK, lda = g.lda;
    unsigned voffA[2], voffB[2];
#pragma unroll
    for (int i = 0; i < 2; ++i) { int R, C; stage_rc(tid * 16 + i * 8192, R, C); const int Rb = (R & ~31) + perm32(R & 31);
        voffA[i] = (unsigned)(R * lda + C) * 2u; voffB[i] = (unsigned)(Rb * K + C) * 2u; }
    const size_t kstep = (size_t)(BK * 2);
    const size_t hstepA = (size_t)HALF * lda * 2, hstepB = (size_t)HALF * K * 2;
    const size_t tstepA = 2 * hstepA, tstepB = 2 * hstepB;
    const unsigned ldsw = (unsigned)wid * 1024u;
    const int aoff = lds_byte(wr * 64 + fr, fq * 8), boff = lds_byte(wc * 32 + fr, fq * 8);
#define PG8_SA(b, h) (((b) * 2 + (h)) * HTB)
#define PG8_SB(b, h) ((4 + (b) * 2 + (h)) * HTB)
#define PG8_STAGE(bufoff, gbase, voff) do { _Pragma("unroll") for (int _i = 0; _i < 2; ++_i) \
        __builtin_amdgcn_global_load_lds((const unsigned*)((const char*)(gbase) + (voff)[_i]), (LAS unsigned*)(lds + (bufoff) + ldsw + _i * 8192), 16, 0, 0); } while (0)
#define PG8_LDA(dst, b, h) do { _Pragma("unroll") for (int m = 0; m < 4; ++m) _Pragma("unroll") for (int k = 0; k < 2; ++k) dst[m][k] = *(const LAS bf16x8*)(lds + PG8_SA(b, h) + aoff + m * 2048 + k * 1024); } while (0)
#define PG8_LDB(dst, b, h) do { _Pragma("unroll") for (int n = 0; n < 2; ++n) _Pragma("unroll") for (int k = 0; k < 2; ++k) dst[n][k] = *(const LAS bf16x8*)(lds + PG8_SB(b, h) + boff + n * 2048 + k * 1024); } while (0)
#define PG8_MMA(ai, bj, At, Bt) do { __builtin_amdgcn_s_setprio(1); _Pragma("unroll") for (int m = 0; m < 4; ++m) _Pragma("unroll") for (int n = 0; n < 2; ++n) _Pragma("unroll") for (int k = 0; k < 2; ++k) \
        acc[ai][bj][m][n] = __builtin_amdgcn_mfma_f32_16x16x32_bf16(Bt[n][k], At[m][k], acc[ai][bj][m][n], 0, 0, 0); __builtin_amdgcn_s_setprio(0); } while (0)
#define PG8_WAIT_V(n) asm volatile("s_waitcnt vmcnt(" #n ")" ::: "memory")
#define PG8_WAIT_L(n) asm volatile("s_waitcnt lgkmcnt(" #n ")" ::: "memory")
#define PG8_BAR __builtin_amdgcn_s_barrier()
#define PG8_SCHED __builtin_amdgcn_sched_barrier(0)
    Unit cur, nxt; int ui = 0;
    if (!S.next(0, cur)) return;
    const unsigned stoff = (unsigned)(((lane >> 2) * 16 + (lane & 3) * 4) * 4);
#define PG8_STATS(pm_, buf_) do { if constexpr (Epi::STATS) { const char* sp_ = (const char*)E.ssq + ((size_t)(pm_) * 256 + wid * 32) * 64; \
        __builtin_amdgcn_global_load_lds((const unsigned*)(sp_ + stoff), (LAS unsigned*)(lds + 131072 + (buf_) * 16384 + wid * 2048), 16, 0, 0); \
        __builtin_amdgcn_global_load_lds((const unsigned*)(sp_ + 1024 + stoff), (LAS unsigned*)(lds + 131072 + (buf_) * 16384 + wid * 2048 + 1024), 16, 0, 0); } } while (0)
    PG8_STATS(cur.pm, 0);
    f32x4 acc[2][2][4][2];
#pragma unroll
    for (int a = 0; a < 2; ++a)
#pragma unroll
        for (int b = 0; b < 2; ++b)
#pragma unroll
            for (int m = 0; m < 4; ++m)
#pragma unroll
                for (int n = 0; n < 2; ++n) acc[a][b][m][n] = (f32x4){0.f, 0.f, 0.f, 0.f};
    bf16x8 At[4][2], B0[2][2], B1[2][2];
    const char* cA = (const char*)g.A + (size_t)cur.pm * tstepA; const char* cB = (const char*)g.Bt + (size_t)cur.pn * tstepB;
    PG8_STAGE(PG8_SB(0, 0), cB, voffB); PG8_STAGE(PG8_SB(0, 1), cB + hstepB, voffB); PG8_STAGE(PG8_SA(0, 0), cA, voffA); PG8_STAGE(PG8_SA(0, 1), cA + hstepA, voffA);
    if (wr == 1) PG8_BAR;
    PG8_WAIT_V(2); PG8_BAR;
    PG8_STAGE(PG8_SB(1, 0), cB + kstep, voffB); PG8_STAGE(PG8_SA(1, 0), cA + kstep, voffA); PG8_STAGE(PG8_SB(1, 1), cB + hstepB + kstep, voffB);
    PG8_WAIT_V(6); PG8_BAR;
    for (;;) {
        const bool has_next = S.next(ui + 1, nxt);
        const char* nA = has_next ? (const char*)g.A + (size_t)nxt.pm * tstepA : cA; const char* nB = has_next ? (const char*)g.Bt + (size_t)nxt.pn * tstepB : cB;
        for (int t = 0; t < nt; t += 2) {
            const bool last = (t == nt - 2);
            const char* a1 = cA + (size_t)(t + 1) * kstep;
            const char* a2 = last ? nA : cA + (size_t)(t + 2) * kstep; const char* b2 = last ? nB : cB + (size_t)(t + 2) * kstep;
            const char* a3 = a2 + kstep; const char* b3 = b2 + kstep;
            PG8_LDB(B0, 0, 0); PG8_LDB(B1, 0, 1); PG8_SCHED; PG8_LDA(At, 0, 0); PG8_STAGE(PG8_SA(1, 1), a1 + hstepA, voffA);
            PG8_WAIT_V(8); PG8_WAIT_L(0); PG8_BAR; PG8_MMA(0, 0, At, B0); PG8_MMA(0, 1, At, B1); PG8_BAR; PG8_SCHED;
            PG8_LDA(At, 0, 1); PG8_STAGE(PG8_SB(0, 0), b2, voffB); PG8_STAGE(PG8_SB(0, 1), b2 + hstepB, voffB); PG8_STAGE(PG8_SA(0, 0), a2, voffA);
            PG8_WAIT_V(8); PG8_WAIT_L(0); PG8_BAR; PG8_MMA(1, 0, At, B0); PG8_MMA(1, 1, At, B1); PG8_BAR; PG8_SCHED;
            PG8_LDB(B0, 1, 0); PG8_LDB(B1, 1, 1); PG8_SCHED; PG8_LDA(At, 1, 0); PG8_STAGE(PG8_SA(0, 1), a2 + hstepA, voffA);
            PG8_WAIT_V(8); PG8_WAIT_L(0); PG8_BAR; PG8_MMA(0, 0, At, B0); PG8_MMA(0, 1, At, B1); PG8_BAR; PG8_SCHED;
            PG8_LDA(At, 1, 1); PG8_STAGE(PG8_SB(1, 0), b3, voffB); PG8_STAGE(PG8_SB(1, 1), b3 + hstepB, voffB); PG8_STAGE(PG8_SA(1, 0), a3, voffA);
            PG8_WAIT_V(8); PG8_WAIT_L(0); PG8_BAR; PG8_MMA(1, 0, At, B0); PG8_MMA(1, 1, At, B1); PG8_BAR; PG8_SCHED;
        }
        if (wr == 0) PG8_BAR;
        E(acc, cur, wr, wc, fr, fq, (const LAS float*)(lds + 131072 + (ui & 1) * 16384));
        if (!has_next) break;
#pragma unroll
        for (int a = 0; a < 2; ++a)
#pragma unroll
            for (int b = 0; b < 2; ++b)
#pragma unroll
                for (int m = 0; m < 4; ++m)
#pragma unroll
                    for (int n = 0; n < 2; ++n) acc[a][b][m][n] = (f32x4){0.f, 0.f, 0.f, 0.f};
        cur = nxt; cA = nA; cB = nB; ++ui;
        PG8_STATS(cur.pm, ui & 1);
        if (wr == 1) PG8_BAR;
    }
    PG8_WAIT_V(0);
    PG8_BAR;
#undef PG8_STATS
#undef PG8_SA
#undef PG8_SB
#undef PG8_STAGE
#undef PG8_LDA
#undef PG8_LDB
#undef PG8_MMA
#undef PG8_WAIT_V
#undef PG8_WAIT_L
#undef PG8_BAR
#undef PG8_SCHED
}
}

struct EpiInProj {
    static constexpr bool STATS = true;
    bf16_t* O; const float* ssq; const f32x2* rope;
    __device__ __forceinline__ void operator()(const f32x4 (&acc)[2][2][4][2], const pg8::Unit& u, int wr, int wc, int fr, int fq, const LAS float* stats) const {
        const int pn = u.pn; const bool rot = (pn == 2 || pn == 3 || pn == 8 || pn == 9); const float qs = pn < 4 ? QSCALE : 1.0f;
        const int rl0 = wr * 64 + fr, row0 = u.pm * 256 + rl0;
        const int cin = wc * 32 + 8 * fq;
#pragma unroll
        for (int ai = 0; ai < 2; ++ai) {
#pragma unroll
          for (int mp = 0; mp < 2; ++mp) {
            f32x4 rc[4][2][2];
            if (rot) {
#pragma unroll
                for (int m = 2 * mp; m < 2 * mp + 2; ++m) { const int t = tok_pos(row0 + ai * 128 + m * 16);
#pragma unroll
                    for (int bj = 0; bj < 2; ++bj) { const f32x4* rp = (const f32x4*)(rope + (size_t)t * 32 + (((bj * 128 + cin) & 63) >> 1)); rc[m][bj][0] = rp[0]; rc[m][bj][1] = rp[1]; } }
            }
#pragma unroll
            for (int m = 2 * mp; m < 2 * mp + 2; ++m) {
                const int row = row0 + ai * 128 + m * 16; const float rs = rstd_lds(stats, rl0 + ai * 128 + m * 16) * qs;
#pragma unroll
                for (int bj = 0; bj < 2; ++bj) {
                    const int col0 = pn * 256 + bj * 128 + cin;
                    f32x4 v0 = acc[ai][bj][m][0] * rs, v1 = acc[ai][bj][m][1] * rs;
                    if (rot) {
                        const f32x4 c0 = rc[m][bj][0], c1 = rc[m][bj][1];
                        f32x4 w0, w1;
                        w0[0] = v0[0] * c0[0] - v0[1] * c0[1]; w0[1] = v0[1] * c0[0] + v0[0] * c0[1];
                        w0[2] = v0[2] * c0[2] - v0[3] * c0[3]; w0[3] = v0[3] * c0[2] + v0[2] * c0[3];
                        w1[0] = v1[0] * c1[0] - v1[1] * c1[1]; w1[1] = v1[1] * c1[0] + v1[0] * c1[1];
                        w1[2] = v1[2] * c1[2] - v1[3] * c1[3]; w1[3] = v1[3] * c1[2] + v1[2] * c1[3];
                        v0 = w0; v1 = w1;
                    }
                    u32x4 w; w.x = cvt_pk_bf16(v0[0], v0[1]); w.y = cvt_pk_bf16(v0[2], v0[3]); w.z = cvt_pk_bf16(v1[0], v1[1]); w.w = cvt_pk_bf16(v1[2], v1[3]);
                    *(u32x4*)(O + (size_t)row * NQKV + col0) = w;
                }
            }
            __builtin_amdgcn_sched_barrier(0);
          }
        }
    }
};
struct EpiResid {
    static constexpr bool STATS = false;
    bf16_t* XB; float* ssq_next;
    __device__ __forceinline__ void operator()(const f32x4 (&acc)[2][2][4][2], const pg8::Unit& u, int wr, int wc, int fr, int fq, const LAS float*) const {
        const int row0 = u.pm * 256 + wr * 64 + fr; const int colb = u.pn * 256 + wc * 32 + 8 * fq;
#pragma unroll
        for (int ai = 0; ai < 2; ++ai) {
            u32x4 xo[4][2];
#pragma unroll
            for (int m = 0; m < 4; ++m)
#pragma unroll
                for (int bj = 0; bj < 2; ++bj) xo[m][bj] = *(const u32x4*)(XB + (size_t)(row0 + ai * 128 + m * 16) * DM + colb + bj * 128);
#pragma unroll
            for (int m = 0; m < 4; ++m) {
                const int row = row0 + ai * 128 + m * 16; float s = 0.f;
#pragma unroll
                for (int bj = 0; bj < 2; ++bj) {
                    const u32x4 o = xo[m][bj]; const f32x4 a0 = acc[ai][bj][m][0], a1 = acc[ai][bj][m][1];
                    u32x4 w;
                    w.x = cvt_pk_bf16(__uint_as_float(o.x << 16) + a0[0], __uint_as_float(o.x & 0xffff0000u) + a0[1]);
                    w.y = cvt_pk_bf16(__uint_as_float(o.y << 16) + a0[2], __uint_as_float(o.y & 0xffff0000u) + a0[3]);
                    w.z = cvt_pk_bf16(__uint_as_float(o.z << 16) + a1[0], __uint_as_float(o.z & 0xffff0000u) + a1[1]);
                    w.w = cvt_pk_bf16(__uint_as_float(o.w << 16) + a1[2], __uint_as_float(o.w & 0xffff0000u) + a1[3]);
                    *(u32x4*)(XB + (size_t)row * DM + colb + bj * 128) = w;
                    const float r0 = __uint_as_float(w.x << 16), r1 = __uint_as_float(w.x & 0xffff0000u), r2 = __uint_as_float(w.y << 16), r3 = __uint_as_float(w.y & 0xffff0000u);
                    const float r4 = __uint_as_float(w.z << 16), r5 = __uint_as_float(w.z & 0xffff0000u), r6 = __uint_as_float(w.w << 16), r7 = __uint_as_float(w.w & 0xffff0000u);
                    s += ((r0 * r0 + r1 * r1) + (r2 * r2 + r3 * r3)) + ((r4 * r4 + r5 * r5) + (r6 * r6 + r7 * r7));
                }
                s += swz_xor<16>(s);
                { auto rr = __builtin_amdgcn_permlane32_swap(__float_as_uint(s), __float_as_uint(s), false, false); s = __uint_as_float(rr[0]) + __uint_as_float(rr[1]); }
                if (fq == 0) ssq_next[(size_t)row * 16 + u.pn * 4 + wc] = s;
            }
        }
    }
};
struct EpiUp {
    static constexpr bool STATS = true;
    bf16_t* H; float* HB; const float* ssq; const float* cw; const float* cb;
    __device__ __forceinline__ void operator()(const f32x4 (&acc)[2][2][4][2], const pg8::Unit& u, int wr, int wc, int fr, int fq, const LAS float* stats) const {
        const int ffc0 = u.pn * 128 + wc * 32 + 8 * fq;
        const unsigned long long is0 = __ballot(fr == 0), is15 = __ballot(fr == 15);
#pragma unroll
        for (int ai = 0; ai < 2; ++ai) {
            const int rowbase = u.pm * 256 + ai * 128 + wr * 64; const int grp = rowbase >> 6;
            float rs[4];
#pragma unroll
            for (int m = 0; m < 4; ++m) rs[m] = rstd_lds(stats, ai * 128 + wr * 64 + 16 * m + fr);
            u32x2 keep[4];
#pragma unroll
            for (int n = 0; n < 2; ++n) {
                const f32x4 w0 = *(const f32x4*)(cw + ffc0 + 4 * n), w1 = *(const f32x4*)(cw + DFF + ffc0 + 4 * n), w2 = *(const f32x4*)(cw + 2 * DFF + ffc0 + 4 * n), bb = *(const f32x4*)(cb + ffc0 + 4 * n);
                f32x4 g[4], R[4], Lr[4], up4[4], dn4[4];
#pragma unroll
                for (int m = 0; m < 4; ++m) { g[m] = acc[ai][0][m][n] * rs[m];
#pragma unroll
                    for (int e = 0; e < 4; ++e) { R[m][e] = __int_as_float(__builtin_amdgcn_update_dpp(0, __float_as_int(g[m][e]), 0x121, 0xf, 0xf, false));
                        Lr[m][e] = __int_as_float(__builtin_amdgcn_update_dpp(0, __float_as_int(g[m][e]), 0x12F, 0xf, 0xf, false)); } }
#pragma unroll
                for (int m = 0; m < 4; ++m)
#pragma unroll
                    for (int e = 0; e < 4; ++e) {
                        float a = R[m][e], b = R[m > 0 ? m - 1 : 0][e], c = Lr[m][e], d = Lr[m < 3 ? m + 1 : 3][e];
                        asm volatile("v_cndmask_b32 %0, %1, %2, %3" : "=v"(up4[m][e]) : "v"(a), "v"(b), "s"(is0));
                        asm volatile("v_cndmask_b32 %0, %1, %2, %3" : "=v"(dn4[m][e]) : "v"(c), "v"(d), "s"(is15));
                    }
#pragma unroll
                for (int m = 0; m < 4; ++m) {
                    const f32x4 v = acc[ai][1][m][n] * rs[m];
                    const f32x4 up = up4[m];
                    const f32x4 dn = dn4[m];
                    const bool first = (m == 0) && (fr == 0), last = (m == 3) && (fr == 15);
                    f32x4 x = w1 * g[m] + bb;
                    if (!first) x += w0 * up;
                    if (!last) x += w2 * dn;
                    if (first || last) {
                        float* hb = HB + (size_t)((grp * 2 + (last ? 1 : 0)) * 3) * DFF + ffc0 + 4 * n;
                        *(f32x4*)hb = x; *(f32x4*)(hb + DFF) = v; *(f32x4*)(hb + 2 * DFF) = g[m];
                    } else {
                        const f32x4 hv = gelu4(x) * v;
                        u32x2 w; w.x = cvt_pk_bf16(hv[0], hv[1]); w.y = cvt_pk_bf16(hv[2], hv[3]);
                        if (n == 0) keep[m] = w;
                        else { u32x4 w4; w4.x = keep[m].x; w4.y = keep[m].y; w4.z = w.x; w4.w = w.y; *(u32x4*)(H + (size_t)(rowbase + 16 * m + fr) * DFF + ffc0) = w4; }
                    }
                }
                __builtin_amdgcn_sched_barrier(0);
            }
        }
    }
};

namespace att {
constexpr float THRL = 10.f;
#define KSWZ(row, colB) ((row) * 256 + ((colB) ^ (((row) & 15) << 4)))
#define SBAR() __builtin_amdgcn_sched_barrier(0)
__device__ __forceinline__ int crow(int r, int hi) { return (r & 3) + 8 * (r >> 2) + 4 * hi; }
__device__ __forceinline__ void softmax_tile(f32x16& p0, f32x16& p1, float& m_reg, float& l_reg, float& alpha, bf16x8& pa0, bf16x8& pa1, bf16x8& pa2, bf16x8& pa3) {
    float pmax = p0[0];
#pragma unroll
    for (int r = 1; r < 16; ++r) pmax = fmaxf(pmax, p0[r]);
#pragma unroll
    for (int r = 0; r < 16; ++r) pmax = fmaxf(pmax, p1[r]);
    { auto rr = __builtin_amdgcn_permlane32_swap(__float_as_uint(pmax), __float_as_uint(pmax), false, false);
      pmax = fmaxf(__uint_as_float(rr[0]), __uint_as_float(rr[1])); }
    float mn;
    if (__builtin_expect(__all(pmax - m_reg <= THRL), 1)) { mn = m_reg; alpha = 1.f; }
    else { mn = fmaxf(m_reg, pmax); alpha = __builtin_amdgcn_exp2f(m_reg - mn); m_reg = mn; }
#pragma unroll
    for (int r = 0; r < 16; ++r) p0[r] = __builtin_amdgcn_exp2f(p0[r] - mn);
#pragma unroll
    for (int r = 0; r < 16; ++r) p1[r] = __builtin_amdgcn_exp2f(p1[r] - mn);
    float ps = 0;
#pragma unroll
    for (int r = 0; r < 16; ++r) ps += p0[r];
#pragma unroll
    for (int r = 0; r < 16; ++r) ps += p1[r];
    { auto rr = __builtin_amdgcn_permlane32_swap(__float_as_uint(ps), __float_as_uint(ps), false, false);
      ps = __uint_as_float(rr[0]) + __uint_as_float(rr[1]); }
    l_reg = l_reg * alpha + ps;
#define PK4(P, BASE, OUT) do { unsigned a0 = cvt_pk_bf16(P[BASE + 0], P[BASE + 1]), a1 = cvt_pk_bf16(P[BASE + 2], P[BASE + 3]);   \
    unsigned b0 = cvt_pk_bf16(P[BASE + 4], P[BASE + 5]), b1 = cvt_pk_bf16(P[BASE + 6], P[BASE + 7]);                              \
    auto r0 = __builtin_amdgcn_permlane32_swap(a0, b0, false, false); auto r1 = __builtin_amdgcn_permlane32_swap(a1, b1, false, false); \
    u32x4 w = {r0[0], r1[0], r0[1], r1[1]}; OUT = __builtin_bit_cast(bf16x8, w); } while (0)
    PK4(p0, 0, pa0); PK4(p0, 8, pa1); PK4(p1, 0, pa2); PK4(p1, 8, pa3);
#undef PK4
}
__device__ __forceinline__ void qkt4(f32x16& p0, f32x16& p1, const LAS unsigned char* Ks, const bf16x8* qr, int dc0, int r32, int hi) {
    p0 = f32x16{}; p1 = f32x16{};
#pragma unroll
    for (int d0 = 0; d0 < 4; ++d0) { const int cb = ((dc0 + d0) * 16 + hi * 8) * 2;
        const bf16x8 b0 = *(const LAS bf16x8*)(Ks + KSWZ(r32, cb));
        const bf16x8 b1 = *(const LAS bf16x8*)(Ks + KSWZ(32 + r32, cb));
        p0 = __builtin_amdgcn_mfma_f32_32x32x16_bf16(b0, qr[d0], p0, 0, 0, 0);
        p1 = __builtin_amdgcn_mfma_f32_32x32x16_bf16(b1, qr[d0], p1, 0, 0, 0); }
}
__device__ __forceinline__ int v_rd_base(int lane) { return ((lane & 3) << 3) | (((lane >> 2) & 3) << 6) | (((lane >> 4) & 1) << 5) | (((lane >> 5) & 1) << 8); }
constexpr int v_rd_off(int d0, int ks, int half) { return d0 * 512 + ks * 4096 + half * 2048; }
template <int OFF> __device__ __forceinline__ s16x4 tr_read(int vb) {
    s16x4 r; asm volatile("ds_read_b64_tr_b16 %0, %1 offset:%2" : "=&v"(r) : "v"(vb), "i"(OFF) : "memory"); return r;
}
#define PKV(L, H) (bf16x8){L[0], L[1], L[2], L[3], H[0], H[1], H[2], H[3]}
template <int D0> __device__ __forceinline__ void pv_two(f32x16& oa, f32x16& ob, int vb, const bf16x8 (&pa)[4], const bf16x8 (&pb)[4]) {
    const s16x4 l0 = tr_read<v_rd_off(D0, 0, 0)>(vb), h0 = tr_read<v_rd_off(D0, 0, 1)>(vb), l1 = tr_read<v_rd_off(D0, 1, 0)>(vb), h1 = tr_read<v_rd_off(D0, 1, 1)>(vb);
    const s16x4 l2 = tr_read<v_rd_off(D0, 2, 0)>(vb), h2 = tr_read<v_rd_off(D0, 2, 1)>(vb), l3 = tr_read<v_rd_off(D0, 3, 0)>(vb), h3 = tr_read<v_rd_off(D0, 3, 1)>(vb);
    asm volatile("s_waitcnt lgkmcnt(0)" ::: "memory"); SBAR();
    oa = __builtin_amdgcn_mfma_f32_32x32x16_bf16(pa[0], PKV(l0, h0), oa, 0, 0, 0); ob = __builtin_amdgcn_mfma_f32_32x32x16_bf16(pb[0], PKV(l0, h0), ob, 0, 0, 0);
    oa = __builtin_amdgcn_mfma_f32_32x32x16_bf16(pa[1], PKV(l1, h1), oa, 0, 0, 0); ob = __builtin_amdgcn_mfma_f32_32x32x16_bf16(pb[1], PKV(l1, h1), ob, 0, 0, 0);
    oa = __builtin_amdgcn_mfma_f32_32x32x16_bf16(pa[2], PKV(l2, h2), oa, 0, 0, 0); ob = __builtin_amdgcn_mfma_f32_32x32x16_bf16(pb[2], PKV(l2, h2), ob, 0, 0, 0);
    oa = __builtin_amdgcn_mfma_f32_32x32x16_bf16(pa[3], PKV(l3, h3), oa, 0, 0, 0); ob = __builtin_amdgcn_mfma_f32_32x32x16_bf16(pb[3], PKV(l3, h3), ob, 0, 0, 0);
}
template <int D0> __device__ __forceinline__ void pv_one(f32x16& oa, int vb, const bf16x8 (&pa)[4]) {
    const s16x4 l0 = tr_read<v_rd_off(D0, 0, 0)>(vb), h0 = tr_read<v_rd_off(D0, 0, 1)>(vb), l1 = tr_read<v_rd_off(D0, 1, 0)>(vb), h1 = tr_read<v_rd_off(D0, 1, 1)>(vb);
    const s16x4 l2 = tr_read<v_rd_off(D0, 2, 0)>(vb), h2 = tr_read<v_rd_off(D0, 2, 1)>(vb), l3 = tr_read<v_rd_off(D0, 3, 0)>(vb), h3 = tr_read<v_rd_off(D0, 3, 1)>(vb);
    asm volatile("s_waitcnt lgkmcnt(0)" ::: "memory"); SBAR();
    oa = __builtin_amdgcn_mfma_f32_32x32x16_bf16(pa[0], PKV(l0, h0), oa, 0, 0, 0);
    oa = __builtin_amdgcn_mfma_f32_32x32x16_bf16(pa[1], PKV(l1, h1), oa, 0, 0, 0);
    oa = __builtin_amdgcn_mfma_f32_32x32x16_bf16(pa[2], PKV(l2, h2), oa, 0, 0, 0);
    oa = __builtin_amdgcn_mfma_f32_32x32x16_bf16(pa[3], PKV(l3, h3), oa, 0, 0, 0);
}
template <int HALF>
__device__ __forceinline__ void na_tile(f32x16& p0, f32x16& p1, const LAS float* bl, int relb, float& m_reg, float& l_reg, float& alpha, bf16x8 (&pa)[3]) {
    f32x16& F = HALF ? p1 : p0; f32x16& S = HALF ? p0 : p1;
    constexpr int SB = HALF ? 12 : 0, FT = HALF ? 32 : 0, ST = HALF ? 0 : 32;
#pragma unroll
    for (int rr = 0; rr < 16; ++rr) { const int kc = FT + (rr & 3) + 8 * (rr >> 2); const float b = bl[kc]; const bool ok = (unsigned)(kc + relb) < 16u; F[rr] = ok ? F[rr] + b : -INFINITY; }
#pragma unroll
    for (int i = 0; i < 4; ++i) { const int rr = SB + i; const int kc = ST + (rr & 3) + 8 * (rr >> 2); const float b = bl[kc]; const bool ok = (unsigned)(kc + relb) < 16u; S[rr] = ok ? S[rr] + b : -INFINITY; }
    float pmax = F[0];
#pragma unroll
    for (int r = 1; r < 16; ++r) pmax = fmaxf(pmax, F[r]);
#pragma unroll
    for (int i = 0; i < 4; ++i) pmax = fmaxf(pmax, S[SB + i]);
    { auto rr = __builtin_amdgcn_permlane32_swap(__float_as_uint(pmax), __float_as_uint(pmax), false, false);
      pmax = fmaxf(__uint_as_float(rr[0]), __uint_as_float(rr[1])); }
    float mn;
    if (__builtin_expect(__all(pmax - m_reg <= THRL), 1)) { mn = m_reg; alpha = 1.f; }
    else { mn = fmaxf(m_reg, pmax); alpha = __builtin_amdgcn_exp2f(m_reg - mn); m_reg = mn; }
    float ps = 0;
#pragma unroll
    for (int r = 0; r < 16; ++r) { F[r] = __builtin_amdgcn_exp2f(F[r] - mn); ps += F[r]; }
#pragma unroll
    for (int i = 0; i < 4; ++i) { S[SB + i] = __builtin_amdgcn_exp2f(S[SB + i] - mn); ps += S[SB + i]; S[(SB ^ 4) + i] = 0.f; }
    { auto rr = __builtin_amdgcn_permlane32_swap(__float_as_uint(ps), __float_as_uint(ps), false, false);
      ps = __uint_as_float(rr[0]) + __uint_as_float(rr[1]); }
    l_reg = l_reg * alpha + ps;
#define PK4(P, BASE, OUT) do { unsigned a0 = cvt_pk_bf16(P[BASE + 0], P[BASE + 1]), a1 = cvt_pk_bf16(P[BASE + 2], P[BASE + 3]);   \
    unsigned b0 = cvt_pk_bf16(P[BASE + 4], P[BASE + 5]), b1 = cvt_pk_bf16(P[BASE + 6], P[BASE + 7]);                              \
    auto r0 = __builtin_amdgcn_permlane32_swap(a0, b0, false, false); auto r1 = __builtin_amdgcn_permlane32_swap(a1, b1, false, false); \
    u32x4 w = {r0[0], r1[0], r0[1], r1[1]}; OUT = __builtin_bit_cast(bf16x8, w); } while (0)
    PK4(F, 0, pa[0]); PK4(F, 8, pa[1]); PK4(S, (SB & 8), pa[2]);
#undef PK4
}
template <int D0, int KA, int KB, int KC> __device__ __forceinline__ void pv_three(f32x16& oa, int vb, const bf16x8 (&pa)[3]) {
    const s16x4 l0 = tr_read<v_rd_off(D0, KA, 0)>(vb), h0 = tr_read<v_rd_off(D0, KA, 1)>(vb), l1 = tr_read<v_rd_off(D0, KB, 0)>(vb), h1 = tr_read<v_rd_off(D0, KB, 1)>(vb);
    const s16x4 l2 = tr_read<v_rd_off(D0, KC, 0)>(vb), h2 = tr_read<v_rd_off(D0, KC, 1)>(vb);
    asm volatile("s_waitcnt lgkmcnt(0)" ::: "memory"); SBAR();
    oa = __builtin_amdgcn_mfma_f32_32x32x16_bf16(pa[0], PKV(l0, h0), oa, 0, 0, 0);
    oa = __builtin_amdgcn_mfma_f32_32x32x16_bf16(pa[1], PKV(l1, h1), oa, 0, 0, 0);
    oa = __builtin_amdgcn_mfma_f32_32x32x16_bf16(pa[2], PKV(l2, h2), oa, 0, 0, 0);
}
__device__ __forceinline__ void dma_offsets(int wid, int lane, unsigned (&ko)[2], unsigned (&vo)[2]) {
#pragma unroll
    for (int p = 0; p < 2; ++p) { const int pc = wid * 2 + p;
        { const int row = pc * 4 + (lane >> 4), ch = (lane & 15) ^ (row & 15); ko[p] = (unsigned)(row * NQKV + ch * 8) * 2u; }
        { const int s = pc * 64 + lane, st = s >> 5, wi = s & 31, kk = (st >> 2) * 8 + (wi >> 2), k = (kk & ~0xC) | ((kk & 4) << 1) | ((kk & 8) >> 1), c = (st & 3) * 32 + (wi & 3) * 8;
          vo[p] = (unsigned)(k * NQKV + c) * 2u; } }
}
__device__ __forceinline__ void dma_issue(const char* Kg, const char* Vg, const unsigned (&ko)[2], const unsigned (&vo)[2], LAS unsigned char* L, int kbuf, int vbuf, int wid) {
#pragma unroll
    for (int p = 0; p < 2; ++p) {
        __builtin_amdgcn_global_load_lds((const unsigned*)(Kg + ko[p]), (LAS unsigned*)(L + A_OFF_K + kbuf * 16384 + (wid * 2 + p) * 1024), 16, 0, 0);
        __builtin_amdgcn_global_load_lds((const unsigned*)(Vg + vo[p]), (LAS unsigned*)(L + A_OFF_V + vbuf * 16384 + (wid * 2 + p) * 1024), 16, 0, 0);
    }
}
#define TILE_SYNC() do { asm volatile("s_waitcnt vmcnt(0)" ::: "memory"); __syncthreads(); } while (0)
#define RESC1(o, nb, a) do { if (__any((a) < 1.f)) { if (hi == 0) al_l[r32] = (a); asm volatile("s_waitcnt lgkmcnt(0)" ::: "memory"); \
    _Pragma("unroll") for (int d_ = 0; d_ < nb; ++d_) _Pragma("unroll") for (int r_ = 0; r_ < 16; ++r_) o[d_][r_] *= al_l[crow(r_, hi)]; \
    asm volatile("s_waitcnt lgkmcnt(0)" ::: "memory"); } } while (0)

__device__ __forceinline__ void diff_unit(bf16_t* QKV, int row0, int T, int q0, int h, float lam, float oscale, const float* subg, LAS unsigned char* L, int wave_s) {
    const int tid = opaque_tid(wave_s), wid = __builtin_amdgcn_readfirstlane(tid >> 6), lane = tid & 63, r32 = lane & 31, hi = lane >> 5;
    LAS float* al_l = (LAS float*)(L + A_OFF_WS) + wid * 64; LAS float* li_l = al_l + 32;
    const int qrow0 = row0 + q0 + wid * 32;
    LAS unsigned char* Qs = L + A_OFF_Q + wid * 8704 + r32 * 272 + hi * 16;
    bf16x8 q1r[4];
    { const bf16_t* Qw = QKV + (size_t)(qrow0 + r32) * NQKV + C_QB + h * 128 + hi * 8;
#pragma unroll
      for (int d0 = 0; d0 < 4; ++d0) q1r[d0] = *(const bf16x8*)(Qw + d0 * 16);
#pragma unroll
      for (int d0 = 4; d0 < 8; ++d0) *(LAS bf16x8*)(Qs + d0 * 32) = *(const bf16x8*)(Qw + d0 * 16); }
    const char* Kg = (const char*)(QKV + (size_t)row0 * NQKV + C_KB + h * 128);
    const char* Vg = (const char*)(QKV + (size_t)row0 * NQKV + C_VB + h * 128);
    const int vb0 = (int)(unsigned)(uintptr_t)(L + A_OFF_V) + v_rd_base(lane);
    const size_t tstep = (size_t)64 * NQKV * 2;
    const int NT = T / 64;
    f32x16 o1[4] = {}, o2[4] = {};
    float m1 = -1e30f, m2 = -1e30f, l1 = 0.f, l2 = 0.f;
    const int trailing = wid >> 2;
    unsigned go[2];
    { unsigned ko4[2], vo4[2];
      dma_offsets((wid & 3) * 2, lane, ko4, vo4); go[0] = trailing ? vo4[0] : ko4[0]; go[1] = trailing ? vo4[1] : ko4[1]; }
    const unsigned go23 = (trailing ? 4u : 8u) * (unsigned)(NQKV * 2), gox = trailing ? 0u : 0x80u;
    const char* Gsrc = trailing ? Vg : Kg;
    const int gdst = (trailing ? A_OFF_V : A_OFF_K) + (wid & 3) * 4096;
#define DIFF_DMA(t) do { const char* gs_ = Gsrc + (size_t)(t) * tstep; const int gd_ = gdst + ((t) & 1) * 16384; \
        _Pragma("unroll") for (int p_ = 0; p_ < 4; ++p_) __builtin_amdgcn_global_load_lds((const unsigned*)(gs_ + ((p_ >> 1) ? (go[p_ & 1] ^ gox) + go23 : go[p_ & 1])), (LAS unsigned*)(L + gd_ + p_ * 1024), 16, 0, 0); } while (0)
    DIFF_DMA(0); TILE_SYNC();
    if (trailing) __builtin_amdgcn_s_barrier();
#pragma unroll 1
    for (int t = 0; t < NT; ++t) {
        bf16x8 pa[4], pb[4]; f32x16 p0, p1; float al1, al2;
        if (t + 1 < NT) DIFF_DMA(t + 1);
        { const LAS unsigned char* Ks = L + A_OFF_K + (t & 1) * 16384; bf16x8 qr[4];
          qkt4(p0, p1, Ks, q1r, 0, r32, hi);
          softmax_tile(p0, p1, m1, l1, al1, pa[0], pa[1], pa[2], pa[3]);
#pragma unroll
          for (int d0 = 0; d0 < 4; ++d0) qr[d0] = *(const LAS bf16x8*)(Qs + (d0 + 4) * 32);
          qkt4(p0, p1, Ks, qr, 4, r32, hi); }
        asm volatile("s_waitcnt lgkmcnt(0)" ::: "memory"); __builtin_amdgcn_s_barrier(); asm volatile("" ::: "memory");
        softmax_tile(p0, p1, m2, l2, al2, pb[0], pb[1], pb[2], pb[3]);
        RESC1(o1, 4, al1); RESC1(o2, 4, al2);
        { const int vb = vb0 + (t & 1) * 16384;
          pv_two<0>(o1[0], o2[0], vb, pa, pb); pv_two<1>(o1[1], o2[1], vb, pa, pb); pv_two<2>(o1[2], o2[2], vb, pa, pb); pv_two<3>(o1[3], o2[3], vb, pa, pb); }
        asm volatile("s_waitcnt vmcnt(0) lgkmcnt(0)" ::: "memory"); __builtin_amdgcn_s_barrier(); asm volatile("" ::: "memory");
    }
    if (!trailing) __builtin_amdgcn_s_barrier();
#undef DIFF_DMA
    if (hi == 0) { al_l[r32] = l1; li_l[r32] = l2; } asm volatile("s_waitcnt lgkmcnt(0)" ::: "memory");
    float gsc[4];
#pragma unroll
    for (int d0 = 0; d0 < 4; ++d0) gsc[d0] = subg[d0 * 32 + r32] * oscale;
    bf16_t* Ow = QKV + (size_t)qrow0 * NQKV + C_QB + h * 128 + r32;
#pragma unroll
    for (int r = 0; r < 16; ++r) {
        const int orow = crow(r, hi);
        const float r1 = __builtin_amdgcn_rcpf(al_l[orow]), r2 = lam * __builtin_amdgcn_rcpf(li_l[orow]);
        float v[4]; float ss = 0.f;
#pragma unroll
        for (int d0 = 0; d0 < 4; ++d0) { v[d0] = o1[d0][r] * r1 - o2[d0][r] * r2; ss += v[d0] * v[d0]; }
        ss += swz_xor<1>(ss); ss += swz_xor<2>(ss); ss += swz_xor<4>(ss); ss += swz_xor<8>(ss); ss += swz_xor<16>(ss);
        const float rn = __builtin_amdgcn_rsqf(ss * (1.0f / 128.0f) + EPS);
#pragma unroll
        for (int d0 = 0; d0 < 4; ++d0) { const float y = v[d0] * rn * gsc[d0]; Ow[(size_t)orow * NQKV + d0 * 32] = (bf16_t)(cvt_pk_bf16(y, y) & 0xffffu); }
    }
    asm volatile("s_waitcnt lgkmcnt(0)" ::: "memory");
}

__device__ __forceinline__ void na_unit(bf16_t* QKV, int row0, int R, int rp, int hp, const float* rpb, LAS unsigned char* L, int wave_s) {
    const int tid = opaque_tid(wave_s), wid = __builtin_amdgcn_readfirstlane(tid >> 6), lane = tid & 63, r32 = lane & 31, hi = lane >> 5;
    constexpr int N_OFF_WS = 98304, N_OFF_BIAS = 100352;
    LAS float* al_l = (LAS float*)(L + N_OFF_WS) + wid * 64; LAS float* li_l = al_l + 32;
    LAS float* bias = (LAS float*)(L + N_OFF_BIAS);
    for (int i = tid; i < 2 * 15 * 31; i += 512) bias[i] = rpb[hp * 2 * 15 * 31 + i] * LOG2E;
    const int qrow = wid >> 2, head = (wid >> 1) & 1, half = wid & 1, hh = hp * 2 + head;
    const int r = 2 * rp + qrow;
    const int st = min(max(r - 4, 0), R - 8);
    const int kr_lo = min(max(2 * rp - 4, 0), R - 8), kr_hi = min(max(2 * rp + 1 - 4, 0), R - 8) + 7;
    const int tok0 = row0 + r * 64 + half * 32;
    bf16x8 qr[4];
    { const bf16_t* Qw = QKV + (size_t)(tok0 + r32) * NQKV + C_QA + hh * 64 + hi * 8;
#pragma unroll
      for (int d0 = 0; d0 < 4; ++d0) qr[d0] = *(const bf16x8*)(Qw + d0 * 16); }
    const char* Kg = (const char*)(QKV + (size_t)row0 * NQKV + C_KA + hp * 128);
    const char* Vg = (const char*)(QKV + (size_t)row0 * NQKV + C_VA + hp * 128);
    unsigned ko[2], vo[2]; dma_offsets(wid, lane, ko, vo);
    const int vb0 = (int)(unsigned)(uintptr_t)(L + A_OFF_V) + v_rd_base(lane);
    const size_t tstep = (size_t)64 * NQKV * 2;
    const int c = half * 32 + r32, cs = min(max(c - 8, 0), 48);
    f32x16 o[2] = {};
    float m_reg = -1e30f, l_reg = 0.f;
    dma_issue(Kg + (size_t)kr_lo * tstep, Vg + (size_t)kr_lo * tstep, ko, vo, L, 0, 0, wid);
    dma_issue(Kg + (size_t)(kr_lo + 1) * tstep, Vg + (size_t)(kr_lo + 1) * tstep, ko, vo, L, 1, 1, wid);
    asm volatile("s_waitcnt vmcnt(4) lgkmcnt(0)" ::: "memory"); __builtin_amdgcn_s_barrier(); asm volatile("" ::: "memory");
    int cur = 0, nx2 = 2;
#pragma unroll 1
    for (int kr = kr_lo; kr <= kr_hi; ++kr) {
        if (kr + 2 <= kr_hi) dma_issue(Kg + (size_t)(kr + 2) * tstep, Vg + (size_t)(kr + 2) * tstep, ko, vo, L, nx2, nx2, wid);
        if (kr >= st && kr < st + 8) {
            const LAS unsigned char* Ks = L + A_OFF_K + cur * 16384;
            f32x16 p0, p1; bf16x8 pa[3]; float al;
            qkt4(p0, p1, Ks, qr, head * 4, r32, hi);
            const int dr = kr - r + 7;
            const LAS float* bl = bias + (head * 15 + dr) * 31 + (4 * hi - c + 15);
            const int relb = 4 * hi - cs;
            const int vb = vb0 + cur * 16384;
            if (half == 0) {
                na_tile<0>(p0, p1, bl, relb, m_reg, l_reg, al, pa);
                RESC1(o, 2, al);
                if (head == 0) { pv_three<0, 0, 1, 2>(o[0], vb, pa); pv_three<1, 0, 1, 2>(o[1], vb, pa); } else { pv_three<2, 0, 1, 2>(o[0], vb, pa); pv_three<3, 0, 1, 2>(o[1], vb, pa); }
            } else {
                na_tile<1>(p0, p1, bl, relb, m_reg, l_reg, al, pa);
                RESC1(o, 2, al);
                if (head == 0) { pv_three<0, 2, 3, 1>(o[0], vb, pa); pv_three<1, 2, 3, 1>(o[1], vb, pa); } else { pv_three<2, 2, 3, 1>(o[0], vb, pa); pv_three<3, 2, 3, 1>(o[1], vb, pa); }
            }
        }
        if (kr + 2 <= kr_hi) asm volatile("s_waitcnt vmcnt(4) lgkmcnt(0)" ::: "memory"); else asm volatile("s_waitcnt vmcnt(0) lgkmcnt(0)" ::: "memory");
        __builtin_amdgcn_s_barrier(); asm volatile("" ::: "memory");
        cur = (cur == 2) ? 0 : cur + 1; nx2 = (nx2 == 2) ? 0 : nx2 + 1;
    }
    if (hi == 0) li_l[r32] = l_reg; asm volatile("s_waitcnt lgkmcnt(0)" ::: "memory");
    bf16_t* Ow = QKV + (size_t)tok0 * NQKV + C_QA + hh * 64 + r32;
#pragma unroll
    for (int rr = 0; rr < 16; ++rr) { const int orow = crow(rr, hi); const float rl = __builtin_amdgcn_rcpf(li_l[orow]);
#pragma unroll
        for (int d0 = 0; d0 < 2; ++d0) { const float y = o[d0][rr] * rl; Ow[(size_t)orow * NQKV + d0 * 32] = (bf16_t)(cvt_pk_bf16(y, y) & 0xffffu); } }
    asm volatile("s_waitcnt lgkmcnt(0)" ::: "memory");
}
}

#define XB_TMO      128
#define XB_XCNT(j)  (256  + 64 * (j))
#define XB_XSUB(j)  (1280 + 64 * (j))
#define XB_XGEN(j)  (2304 + 64 * (j))
#define XB_TOP      3328
#define XB_TOPGEN   3392
#define XB_SPIN_CAP (1u << 22)
__device__ __forceinline__ unsigned xb_ld(unsigned* p)              { return __hip_atomic_load(p, __ATOMIC_RELAXED, __HIP_MEMORY_SCOPE_AGENT); }
__device__ __forceinline__ unsigned xb_add(unsigned* p, unsigned v) { return __hip_atomic_fetch_add(p, v, __ATOMIC_RELAXED, __HIP_MEMORY_SCOPE_AGENT); }
__device__ __forceinline__ unsigned xb_xcc_id() { return (unsigned)__builtin_amdgcn_s_getreg((3 << 11) | 20) & 0xFu; }
#define XB_SPIN(cond, bar) do { unsigned _sp = 0; while (cond) { __builtin_amdgcn_s_sleep(1); \
    if ((++_sp & 255u) == 0u) { if (xb_ld(&(bar)[XB_TMO])) break; if (_sp > XB_SPIN_CAP) { atomicAdd(&(bar)[XB_TMO], 1u); break; } } } } while (0)
__device__ __forceinline__ void xcd_barrier_complete(unsigned* bar, unsigned x, unsigned& nloc, unsigned& nx) {
    const unsigned G = gridDim.x * gridDim.y * gridDim.z;
    unsigned sum, cnt, mine, sp = 0u;
    for (;;) {
        sum = 0u; cnt = 0u; mine = 0u;
#pragma unroll
        for (unsigned j = 0; j < 16; ++j) { const unsigned c = xb_ld(&bar[XB_XCNT(j)]); sum += c; cnt += (c > 0u) ? 1u : 0u; mine = (j == x) ? c : mine; }
        if (sum == G) break;
        __builtin_amdgcn_s_sleep(1);
        if ((++sp & 255u) == 0u) { if (xb_ld(&bar[XB_TMO])) break; if (sp > XB_SPIN_CAP) { atomicAdd(&bar[XB_TMO], 1u); break; } }
    }
    nloc = mine > 0u ? mine : 1u; nx = cnt > 0u ? cnt : 1u;
}
__device__ __forceinline__ void xcd_barrier(unsigned* bar, unsigned nloc, unsigned nx, unsigned k, int wave_s) {
    asm volatile("s_waitcnt vmcnt(0)" ::: "memory");
    __syncthreads();
    if (opaque_tid(wave_s) == 0) {
        const unsigned x = xb_xcc_id();
        __builtin_amdgcn_s_waitcnt(0);
        const unsigned old = xb_add(&bar[XB_XSUB(x)], 1u);
        const unsigned gen = k;
        if (old + 1u == (gen + 1u) * nloc) {
            __builtin_amdgcn_fence(__ATOMIC_RELEASE, "agent");
            asm volatile("s_waitcnt vmcnt(0)" ::: "memory");
            const unsigned og = xb_add(&bar[XB_TOP], 1u);
            const unsigned tg = k;
            if (og + 1u == (tg + 1u) * nx) xb_add(&bar[XB_TOPGEN], 1u);
            else XB_SPIN(xb_ld(&bar[XB_TOPGEN]) == tg, bar);
            __builtin_amdgcn_fence(__ATOMIC_ACQUIRE, "agent");
            xb_add(&bar[XB_XGEN(x)], 1u);
            asm volatile("s_waitcnt vmcnt(0)" ::: "memory");
        } else {
            XB_SPIN(xb_ld(&bar[XB_XGEN(x)]) == gen, bar);
            __builtin_amdgcn_fence(__ATOMIC_ACQUIRE, "agent");
            asm volatile("s_waitcnt vmcnt(0)" ::: "memory");
        }
    }
    __syncthreads();
}

struct Args {
    const float* in[17];
    float* out; unsigned char* ws;
};

typedef __attribute__((address_space(4))) const char* karg_t;
__device__ __forceinline__ karg_t kargs() { karg_t p = (karg_t)__builtin_amdgcn_kernarg_segment_ptr(); asm volatile("" : "+s"(p)); return p; }
__device__ __forceinline__ const float* arg_in(int i) { return *(const float* const __attribute__((address_space(4)))*)(kargs() + 8 * i); }
__device__ __forceinline__ float* arg_out() { return *(float* const __attribute__((address_space(4)))*)(kargs() + 8 * 17); }
__device__ __forceinline__ unsigned char* arg_ws() { return *(unsigned char* const __attribute__((address_space(4)))*)(kargs() + 8 * 18); }
template <int MODE>
__device__ __forceinline__ int colmap(int n) {
    if (MODE == 1) {
        if (n < 512) return n;
        if (n < 1024) { const int j = n - 512, blk = j >> 6, p = j & 63; return 1536 + blk * 64 + (p >> 1) + 32 * (p & 1); }
        if (n < 1536) return 512 + (n - 1024);
        if (n < 2048) return 1024 + (n - 1536);
        if (n < 2560) { const int j = n - 2048, blk = j >> 6, p = j & 63; return 2048 + blk * 64 + (p >> 1) + 32 * (p & 1); }
        return n;
    }
    if (MODE == 2) { const int pn = n >> 8, bj = (n >> 7) & 1, j = n & 127; return bj * DFF + pn * 128 + j; }
    return n;
}
template <int MODE>
__device__ __forceinline__ void conv_mat(const float* src, int K, int N, bf16_t* dst, const float* scale, int gtid, int gthreads) {
    const int kch = K / 64; const long items = (long)N * kch;
    for (long it = gtid; it < items; it += gthreads) {
        const int n = (int)(it % N), k0 = (int)(it / N) * 64; const int sc = colmap<MODE>(n);
#pragma unroll
        for (int h = 0; h < 2; ++h) {
            float v[32];
#pragma unroll
            for (int j = 0; j < 32; ++j) v[j] = src[(size_t)(k0 + h * 32 + j) * N + sc];
            if (scale) {
#pragma unroll
                for (int j = 0; j < 32; ++j) v[j] *= scale[k0 + h * 32 + j];
            }
#pragma unroll
            for (int q = 0; q < 4; ++q) { u32x4 w; w.x = cvt_pk_bf16(v[8 * q], v[8 * q + 1]); w.y = cvt_pk_bf16(v[8 * q + 2], v[8 * q + 3]); w.z = cvt_pk_bf16(v[8 * q + 4], v[8 * q + 5]); w.w = cvt_pk_bf16(v[8 * q + 6], v[8 * q + 7]);
                *(u32x4*)(dst + (size_t)n * K + k0 + h * 32 + 8 * q) = w; }
        }
    }
}
__device__ __forceinline__ void convert_layer(int l, unsigned char* wb, int gtid, int gthreads) {
    conv_mat<1>(arg_in(3) + (size_t)l * DM * NQKV, DM, NQKV, (bf16_t*)(wb + W_IN), arg_in(2) + (size_t)l * DM, gtid, gthreads);
    conv_mat<0>(arg_in(10) + (size_t)l * DM * DM, DM, DM, (bf16_t*)(wb + W_OUT), nullptr, gtid, gthreads);
    conv_mat<2>(arg_in(12) + (size_t)l * DM * NUP, DM, NUP, (bf16_t*)(wb + W_UP), arg_in(11) + (size_t)l * DM, gtid, gthreads);
    conv_mat<0>(arg_in(15) + (size_t)l * DFF * DM, DFF, DM, (bf16_t*)(wb + W_DOWN), nullptr, gtid, gthreads);
}

__global__ void __launch_bounds__(512, 2) mega_fwd(Args a) {
    extern __shared__ __attribute__((aligned(16))) unsigned char lds_raw[];
    LAS unsigned char* L = (LAS unsigned char*)lds_raw;
    cg::grid_group grid = cg::this_grid();
    const int G = gridDim.x, bx = blockIdx.x;
    const int wave_s = __builtin_amdgcn_readfirstlane((int)(threadIdx.x >> 6));
    { unsigned* barp = (unsigned*)(arg_ws() + WS_CTL); if (threadIdx.x == 0) (void)xb_add(&barp[XB_XCNT(xb_xcc_id())], 1u); }
    unsigned bar_nloc = 1u, bar_nx = 1u;
#define GRID_BAR(j) xcd_barrier((unsigned*)(arg_ws() + WS_CTL), bar_nloc, bar_nx, (unsigned)(1 + l * 6 + (j)), wave_s)
#define FRAME_IDS() const int tid = opaque_tid(wave_s), lane = tid & 63, wave = wave_s; \
    const int gtid = bx * 512 + tid, gthreads = G * 512, gw = bx * 8 + wave, NGW = G * 8; (void)lane; (void)gtid; (void)gthreads; (void)gw; (void)NGW
#define PTRS() unsigned char* ws = arg_ws(); bf16_t* QKV = (bf16_t*)(ws + WS_QKV); bf16_t* Hb = (bf16_t*)(ws + WS_QKV); bf16_t* XB = (bf16_t*)(ws + WS_XB); \
    float* HB = (float*)(ws + WS_HB); float* SSQ = (float*)(ws + WS_SSQ); f32x2* ROPE = (f32x2*)(ws + WS_ROPE); float* X = arg_out(); \
    (void)QKV; (void)Hb; (void)XB; (void)HB; (void)SSQ; (void)ROPE; (void)X

    {
    FRAME_IDS(); PTRS();
    for (int m = gw; m < M_TOK; m += NGW) {
        const float* src = (m < M_PROMPT) ? arg_in(0) + (size_t)m * DM : arg_in(1) + (size_t)(m - M_PROMPT) * DM;
        float s = 0.f;
        f32x4 xv[4];
#pragma unroll
        for (int j = 0; j < 4; ++j) xv[j] = __builtin_nontemporal_load((const f32x4*)(src + j * 256 + lane * 4));
#pragma unroll
        for (int j = 0; j < 4; ++j) { const f32x4 v = xv[j];
            u32x2 w; w.x = cvt_pk_bf16(v[0], v[1]); w.y = cvt_pk_bf16(v[2], v[3]); *(u32x2*)(XB + (size_t)m * DM + j * 256 + lane * 4) = w;
            const float r0 = __uint_as_float(w.x << 16), r1 = __uint_as_float(w.x & 0xffff0000u), r2 = __uint_as_float(w.y << 16), r3 = __uint_as_float(w.y & 0xffff0000u);
            s += (r0 * r0 + r1 * r1) + (r2 * r2 + r3 * r3); }
#pragma unroll
        for (int o = 1; o < 64; o <<= 1) s += __shfl_xor(s, o);
        if (lane < 16) SSQ[(size_t)m * 16 + lane] = (lane == 0) ? s : 0.f;
    }
    for (int i = gtid; i < 8192 * 32; i += gthreads) {
        const int t = i >> 5, fi = i & 31;
        const float invf = 1.0f / exp2f((float)fi * (13.287712379549449f / 32.0f));
        const float ang = (float)t * invf;
        double rev = (double)ang * 0.15915494309189535; rev -= floor(rev);
        const float fr = (float)rev;
        ROPE[i] = (f32x2){__builtin_amdgcn_cosf(fr), __builtin_amdgcn_sinf(fr)};
    }
    conv_mat<1>(arg_in(3), DM, NQKV, (bf16_t*)(ws + WS_W + W_IN), arg_in(2), gtid, gthreads);
    }
    if (gridDim.x == 0x7fffffffu) grid.sync();
    { unsigned* barp = (unsigned*)(arg_ws() + WS_CTL); unsigned nl, nx_; xcd_barrier_complete(barp, xb_xcc_id(), nl, nx_);
      bar_nloc = (unsigned)__builtin_amdgcn_readfirstlane((int)nl); bar_nx = (unsigned)__builtin_amdgcn_readfirstlane((int)nx_); }
    xcd_barrier((unsigned*)(arg_ws() + WS_CTL), bar_nloc, bar_nx, 0u, wave_s);

#define CONV_Q(ln_, cidx_, lo_, hi_) do { \
        unsigned char* ws_ = arg_ws(); unsigned* cctr = (unsigned*)(ws_ + WS_CTL) + 4048 + (cidx_); \
        unsigned char* wbn = ws_ + WS_W + (size_t)((ln_) & 1) * W_LAYER; const int ln = (ln_); \
        volatile LAS int* cslot = (volatile LAS int*)(L + LDS_BYTES - 16); \
        for (;;) { \
            __syncthreads(); \
            if (opaque_tid(wave_s) == 0) *cslot = (int)__hip_atomic_fetch_add(cctr, 1u, __ATOMIC_RELAXED, __HIP_MEMORY_SCOPE_AGENT); \
            __syncthreads(); \
            const int cb = (lo_) + __builtin_amdgcn_readfirstlane(*cslot); \
            if (cb >= (hi_)) break; \
            const int t = opaque_tid(wave_s); \
            if (cb < 96) conv_mat<1>(arg_in(3) + (size_t)ln * DM * NQKV, DM, NQKV, (bf16_t*)(wbn + W_IN), arg_in(2) + (size_t)ln * DM, cb * 512 + t, 1 << 30); \
            else if (cb < 128) conv_mat<0>(arg_in(10) + (size_t)ln * DM * DM, DM, DM, (bf16_t*)(wbn + W_OUT), nullptr, (cb - 96) * 512 + t, 1 << 30); \
            else if (cb < 304) conv_mat<2>(arg_in(12) + (size_t)ln * DM * NUP, DM, NUP, (bf16_t*)(wbn + W_UP), arg_in(11) + (size_t)ln * DM, (cb - 128) * 512 + t, 1 << 30); \
            else conv_mat<0>(arg_in(15) + (size_t)ln * DFF * DM, DFF, DM, (bf16_t*)(wbn + W_DOWN), nullptr, (cb - 304) * 512 + t, 1 << 30); \
        } } while (0)
#pragma unroll 1
    for (int l = 0; l < DEPTH; ++l) {
#define LPTRS() PTRS(); unsigned char* wb = ws + WS_W + (size_t)(l & 1) * W_LAYER; \
        const float* ssqA = SSQ + (size_t)(2 * l) * SSQ_STAGE; float* ssqB = SSQ + (size_t)(2 * l + 1) * SSQ_STAGE; float* ssqC = SSQ + (size_t)(2 * l + 2) * SSQ_STAGE; (void)wb; (void)ssqA; (void)ssqB; (void)ssqC
        { LPTRS(); pg8::Gemm g{XB, (const bf16_t*)(wb + W_IN), M_TOK, NQKV, DM, DM}; pg8::StaticOrder S; S.init(M_TOK, NQKV, G, bx);
          EpiInProj E{QKV, ssqA, ROPE}; pg8::gemm_phase<EpiInProj>(L, g, S, E, wave_s); }
        if (l == 0) CONV_Q(0, 4, 96, 392);
        GRID_BAR(0);
        {
            FRAME_IDS(); PTRS();
            const float* rpb = arg_in(4) + (size_t)l * 8 * 15 * 31;
            const float lam_init = 0.8f - 0.6f * expf(-0.3f * (float)l);
            float d1 = 0.f, d2 = 0.f;
            for (int i = 0; i < 64; ++i) { d1 += arg_in(5)[l * 64 + i] * arg_in(6)[l * 64 + i]; d2 += arg_in(7)[l * 64 + i] * arg_in(8)[l * 64 + i]; }
            const float lam = expf(d1) - expf(d2) + lam_init;
            const float* subg = arg_in(9) + (size_t)l * 128;
            __syncthreads();
            for (int u = opaque_s(bx); u < 512; u += G) {
                if (u < 256) {
                    const int x = u & 7, j = u >> 3; const int b = x >> 2, h = x & 3;
                    att::diff_unit(QKV, M_PROMPT + b * T_S, T_S, j * 256, h, lam, 1.0f - lam_init, subg, L, wave_s);
                } else {
                    const int v = u - 256, x = v & 7, j = v >> 3; const int bh = 2 * x + (j >> 4), b = bh >> 2, h = bh & 3;
                    att::diff_unit(QKV, b * T_P, T_P, (j & 15) * 256, h, lam, 1.0f - lam_init, subg, L, wave_s);
                }
            }
            {
                const bool xq = (G == 256);
                const int x0 = xq ? (bx & 7) : 0, qlen = xq ? 128 : 1024, nq = xq ? 8 : 1;
                unsigned* ctr0 = (unsigned*)(ws + WS_CTL) + 3520 + l * 128;
                volatile LAS int* slot = (volatile LAS int*)(L + 116736);
                int qi = 0;
                for (;;) {
                    const int x = (x0 + qi) & 7;
                    __syncthreads();
                    if (opaque_tid(wave_s) == 0) *slot = (int)__hip_atomic_fetch_add(ctr0 + x * 16, 1u, __ATOMIC_RELAXED, __HIP_MEMORY_SCOPE_AGENT);
                    __syncthreads();
                    const int n = __builtin_amdgcn_readfirstlane(*slot);
                    if (n >= qlen) { if (++qi >= nq) break; continue; }
                    int rpg = n >> 2, hp = n & 3;
                    if (xq) { const int kk = n >> 5, i = n & 31; rpg = (kk * 8 + x) * 8 + (i >> 2); hp = i & 3; }
                    const int sq = rpg < 128 ? 0 : 1, q = rpg - 128 * sq, b = sq ? (q >> 6) : (q >> 5);
                    att::na_unit(QKV, sq ? M_PROMPT + b * T_S : b * T_P, sq ? 128 : 64, sq ? (q & 63) : (q & 31), hp, rpb, L, wave_s);
                }
                if (l + 1 < DEPTH) CONV_Q(l + 1, l, 0, 392);
            }
        }
        GRID_BAR(1);
        { LPTRS(); pg8::Gemm g{QKV, (const bf16_t*)(wb + W_OUT), M_TOK, DM, DM, NQKV}; pg8::StaticOrder S; S.init(M_TOK, DM, G, bx);
          EpiResid E{XB, ssqB}; pg8::gemm_phase<EpiResid>(L, g, S, E, wave_s); }
        GRID_BAR(2);
        { LPTRS(); pg8::Gemm g{XB, (const bf16_t*)(wb + W_UP), M_TOK, NUP, DM, DM}; pg8::StaticOrder S; S.init(M_TOK, NUP, G, bx);
          EpiUp E{Hb, HB, ssqB, arg_in(13) + (size_t)l * 3 * DFF, arg_in(14) + (size_t)l * DFF}; pg8::gemm_phase<EpiUp>(L, g, S, E, wave_s); }
        GRID_BAR(3);
        {
            FRAME_IDS(); PTRS();
            const float* cw = arg_in(13) + (size_t)l * 3 * DFF;
            for (int i = gtid; i < 1024 * (DFF / 4); i += gthreads) {
                const int bi = i / (DFF / 4), cq = (i % (DFF / 4)) * 4, grp = bi >> 1, which = bi & 1;
                const int row = grp * 64 + (which ? 63 : 0);
                const float* hb = HB + (size_t)(bi * 3) * DFF + cq;
                f32x4 x = *(const f32x4*)hb; const f32x4 v = *(const f32x4*)(hb + DFF);
                const int nrow = which ? row + 1 : row;
                const bool seq_start = (nrow < M_PROMPT) ? ((nrow & (T_P - 1)) == 0) : ((nrow & (T_S - 1)) == 0);
                if (!seq_start) {
                    const int nbi = which ? (grp + 1) * 2 : (grp - 1) * 2 + 1;
                    const f32x4 nb = *(const f32x4*)(HB + (size_t)(nbi * 3 + 2) * DFF + cq);
                    const f32x4 w = *(const f32x4*)(cw + (which ? 2 * DFF : 0) + cq);
                    x += w * nb;
                }
                const f32x4 hval = gelu4(x) * v;
                u32x2 w2; w2.x = cvt_pk_bf16(hval[0], hval[1]); w2.y = cvt_pk_bf16(hval[2], hval[3]);
                *(u32x2*)(Hb + (size_t)row * DFF + cq) = w2;
            }
        }
        GRID_BAR(4);
        { LPTRS(); pg8::Gemm g{Hb, (const bf16_t*)(wb + W_DOWN), M_TOK, DM, DFF, DFF}; pg8::StaticOrder S; S.init(M_TOK, DM, G, bx);
          EpiResid E{XB, ssqC}; pg8::gemm_phase<EpiResid>(L, g, S, E, wave_s); }
        GRID_BAR(5);
    }
    {
        FRAME_IDS(); PTRS();
        const float* ssqF = SSQ + (size_t)8 * SSQ_STAGE; const float* gf = arg_in(16);
        for (int m = gw; m < M_TOK; m += NGW) {
            const float rs = rstd_row(ssqF, m);
#pragma unroll
            for (int j = 0; j < 4; ++j) { const u32x2 w = *(const u32x2*)(XB + (size_t)m * DM + j * 256 + lane * 4); const f32x4 gg = *(const f32x4*)(gf + j * 256 + lane * 4);
                const f32x4 v = {__uint_as_float(w.x << 16), __uint_as_float(w.x & 0xffff0000u), __uint_as_float(w.y << 16), __uint_as_float(w.y & 0xffff0000u)};
                __builtin_nontemporal_store(v * rs * gg, (f32x4*)(X + (size_t)m * DM + j * 256 + lane * 4)); }
        }
    }
}

extern "C" void kernel_launch(void* const* d_in, const int* in_sizes, int n_in, void* d_out, int out_size, void* d_ws, size_t ws_size, hipStream_t stream) {
    static int grid_blocks = 0;
    if (grid_blocks == 0) {
        if (n_in != 17 || out_size != M_TOK * DM || ws_size < WS_END) { fprintf(stderr, "kernel_launch: unexpected shapes / workspace (n_in %d out %d ws %zu need %zu)\n", n_in, out_size, ws_size, (size_t)WS_END); grid_blocks = -1; return; }
        int dev = 0, cus = 0, per_cu = 0;
        hipGetDevice(&dev);
        hipDeviceGetAttribute(&cus, hipDeviceAttributeMultiprocessorCount, dev);
        if (hipFuncSetAttribute((const void*)mega_fwd, hipFuncAttributeMaxDynamicSharedMemorySize, LDS_BYTES) != hipSuccess) { fprintf(stderr, "kernel_launch: hipFuncSetAttribute failed\n"); grid_blocks = -1; return; }
        if (hipOccupancyMaxActiveBlocksPerMultiprocessor(&per_cu, (const void*)mega_fwd, 512, LDS_BYTES) != hipSuccess || per_cu < 1) per_cu = 1;
        (void)hipGetLastError();
        grid_blocks = cus * per_cu;
    }
    if (grid_blocks < 0) return;
    if (hipMemsetAsync((char*)d_ws + WS_CTL, 0, CTL_BYTES, stream) != hipSuccess) { fprintf(stderr, "kernel_launch: memset of the barrier words failed\n"); return; }
    Args a{};
    for (int i = 0; i < 17; ++i) a.in[i] = (const float*)d_in[i];
    a.out = (float*)d_out; a.ws = (unsigned char*)d_ws;
    void* args[] = {&a};
    hipError_t e = hipLaunchCooperativeKernel((const void*)mega_fwd, dim3(grid_blocks), dim3(512), args, LDS_BYTES, stream);
    if (e != hipSuccess) fprintf(stderr, "cooperative launch failed: %s (grid %d)\n", hipGetErrorString(e), grid_blocks);
}
```

```cpp
#include <hip/hip_runtime.h>
#include <hip/hip_cooperative_groups.h>
#include <cstdio>
#include <cstdint>
namespace cg = cooperative_groups;

#define LAS __attribute__((address_space(3)))
typedef unsigned short bf16_t;
typedef short bf16x8 __attribute__((ext_vector_type(8)));
typedef short s16x4 __attribute__((ext_vector_type(4)));
typedef float f32x4 __attribute__((ext_vector_type(4)));
typedef float f32x2 __attribute__((ext_vector_type(2)));
typedef float f32x16 __attribute__((ext_vector_type(16)));
typedef unsigned u32x4 __attribute__((ext_vector_type(4)));
typedef unsigned u32x2 __attribute__((ext_vector_type(2)));

constexpr int M_TOK = 32768, M_PROMPT = 16384, T_P = 4096, T_S = 8192;
constexpr int DM = 1024, NQKV = 3072, DFF = 2816, NUP = 5632, DEPTH = 4;
constexpr float EPS = 1e-6f;
constexpr float LOG2E = 1.4426950408889634f;
constexpr float QSCALE = 0.125f * LOG2E;
constexpr int C_QA = 0, C_QB = 512, C_KA = 1024, C_VA = 1536, C_KB = 2048, C_VB = 2560;

constexpr size_t MiB = 1u << 20;
constexpr size_t WS_QKV = 0;
constexpr size_t WS_XB = 192 * MiB;
constexpr size_t WS_W = 256 * MiB;
constexpr size_t W_IN = 0, W_OUT = (size_t)NQKV * DM * 2, W_UP = W_OUT + (size_t)DM * DM * 2, W_DOWN = W_UP + (size_t)NUP * DM * 2;
constexpr size_t W_LAYER = W_DOWN + (size_t)DM * DFF * 2;
constexpr size_t WS_HB = WS_W + 2 * W_LAYER;
constexpr size_t HB_BYTES = (size_t)1024 * 3 * DFF * 4;
constexpr size_t WS_SSQ = WS_HB + HB_BYTES;
constexpr size_t SSQ_STAGE = (size_t)M_TOK * 16;
constexpr size_t WS_ROPE = WS_SSQ + (size_t)9 * SSQ_STAGE * 4;
constexpr size_t WS_CTL = WS_ROPE + (size_t)8192 * 32 * 8;
constexpr size_t CTL_BYTES = 16384;
constexpr size_t WS_END = WS_CTL + CTL_BYTES;

constexpr int LDS_BYTES = 163840;
constexpr int A_OFF_V = 0  , A_OFF_K = 49152  , A_OFF_WS = 81920, A_OFF_Q = 83968, A_OFF_BIAS = 83968  ;

__device__ __forceinline__ unsigned cvt_pk_bf16(float lo, float hi) { unsigned r; asm volatile("v_cvt_pk_bf16_f32 %0, %1, %2" : "=v"(r) : "v"(lo), "v"(hi)); return r; }
__device__ __forceinline__ int opaque_tid(int wave_s) { int ln; asm volatile("v_mbcnt_lo_u32_b32 %0, -1, 0\n\tv_mbcnt_hi_u32_b32 %0, -1, %0" : "=v"(ln)); return wave_s * 64 + ln; }
__device__ __forceinline__ int opaque_s(int v) { asm volatile("" : "+s"(v)); return v; }
template <int XOR> __device__ __forceinline__ float swz_xor(float v) { return __int_as_float(__builtin_amdgcn_ds_swizzle(__float_as_int(v), (XOR << 10) | 0x1f)); }
__device__ __forceinline__ float rstd_of(float ssq) { return __builtin_amdgcn_rsqf(ssq * (1.0f / DM) + EPS); }
__device__ __forceinline__ float rstd_row(const float* ssqp, int row) {
    const f32x4* p = (const f32x4*)(ssqp + (size_t)row * 16); const f32x4 a = p[0], b = p[1], c = p[2], d = p[3];
    const float s = (((a[0] + a[1]) + (a[2] + a[3])) + ((b[0] + b[1]) + (b[2] + b[3]))) + (((c[0] + c[1]) + (c[2] + c[3])) + ((d[0] + d[1]) + (d[2] + d[3])));
    return rstd_of(s);
}
__device__ __forceinline__ float rstd_lds(const LAS float* st, int r) {
    const LAS f32x4* p = (const LAS f32x4*)(st + r * 16); const f32x4 a = p[0], b = p[1], c = p[2], d = p[3];
    const float s = (((a[0] + a[1]) + (a[2] + a[3])) + ((b[0] + b[1]) + (b[2] + b[3]))) + (((c[0] + c[1]) + (c[2] + c[3])) + ((d[0] + d[1]) + (d[2] + d[3])));
    return rstd_of(s);
}
__device__ __forceinline__ int tok_pos(int row) { return row < M_PROMPT ? (row & (T_P - 1)) : (row & (T_S - 1)); }

__device__ __forceinline__ f32x2 gelu_pk(f32x2 v) {
    const f32x2 av = __builtin_elementwise_abs(v), d = av * 0.2316418882f + 1.0f;
    f32x2 t; t.x = __builtin_amdgcn_rcpf(d.x); t.y = __builtin_amdgcn_rcpf(d.y);
    f32x2 q = t * 0.5307027145f + (-0.7265760135f); q = q * t + 0.7107068705f; q = q * t + (-0.142248368f); q = q * t + 0.127414796f; q = q * t;
    const f32x2 s = (v * v) * (-0.72134752044f);
    f32x2 e; e.x = __builtin_amdgcn_exp2f(s.x); e.y = __builtin_amdgcn_exp2f(s.y);
    const f32x2 m = v * (q * e), r = v - m;
    f32x2 o; o.x = v.x < 0.f ? m.x : r.x; o.y = v.y < 0.f ? m.y : r.y; return o;
}
__device__ __forceinline__ f32x4 gelu4(f32x4 v) { f32x2 a = gelu_pk((f32x2){v[0], v[1]}), b = gelu_pk((f32x2){v[2], v[3]}); return (f32x4){a.x, a.y, b.x, b.y}; }

namespace pg8 {
constexpr int BM = 256, BK = 64, HALF = 128, HTB = HALF * BK * 2, STAGE_BYTES = 8 * HTB, NXCD = 8, WGM = 8;
__host__ __device__ __forceinline__ int lds_byte(int r, int c) { const int st = (r >> 4) * 2 + (c >> 5), rr = r & 15, cc = c & 31, ob = rr * 64 + cc * 2; return st * 1024 + (ob ^ (((ob >> 9) & 1) << 5)); }
__host__ __device__ __forceinline__ void stage_rc(int b, int& R, int& C) { const int st = b / 1024, sb = b % 1024, swz = sb ^ (((sb >> 9) & 1) << 5); R = (st >> 1) * 16 + swz / 64; C = (st & 1) * 32 + (swz % 64) / 2; }
__host__ __device__ __forceinline__ int perm32(int rho) { const int n = rho >> 4, i = rho & 15; return 8 * (i >> 2) + 4 * n + (i & 3); }
struct Unit { int pm, pn; };
struct Gemm { const bf16_t* A; const bf16_t* Bt; int M, N, K, lda; };
struct StaticOrder {
    int nM, nN, nwg, G, c;
    __device__ void init(int M, int N, int G_, int c_) { nM = M / BM; nN = N / BM; nwg = nM * nN; G = G_; c = c_; }
    __device__ bool next(int i, Unit& u) const {
        const long L = (long)i * G + c; if (L >= nwg) return false;
        int wgid = (int)L; { const int q = nwg / NXCD, r = nwg % NXCD, xcd = wgid % NXCD, off = wgid / NXCD; wgid = (xcd < r ? xcd * (q + 1) : r * (q + 1) + (xcd - r) * q) + off; }
        const int nig = WGM * nN, gid = wgid / nig, fm = gid * WGM, gsz = (nM - fm) < WGM ? (nM - fm) : WGM;
        u.pm = fm + ((wgid % nig) % gsz); u.pn = (wgid % nig) / gsz; return true;
    }
};
template <class Epi>
__device__ __forceinline__ void gemm_phase(LAS unsigned char* lds, const Gemm g, const StaticOrder& S, const Epi& E, int wave_s) {
    const int tid = opaque_tid(wave_s), wid = __builtin_amdgcn_readfirstlane(tid >> 6), lane = tid & 63, wr = wid >> 2, wc = wid & 3, fr = lane & 15, fq = lane >> 4;
    const int K = g.K, nt = K / BK, lda = g.lda;
    unsigned voffA[2], voffB[2];
#pragma unroll
    for (int i = 0; i < 2; ++i) { int R, C; stage_rc(tid * 16 + i * 8192, R, C); const int Rb = (R & ~31) + perm32(R & 31);
        voffA[i] = (unsigned)(R * lda + C) * 2u; voffB[i] = (unsigned)(Rb * K + C) * 2u; }
    const size_t kstep = (size_t)(BK * 2);
    const size_t hstepA = (size_t)HALF * lda * 2, hstepB = (size_t)HALF * K * 2;
    const size_t tstepA = 2 * hstepA, tstepB = 2 * hstepB;
    const unsigned ldsw = (unsigned)wid * 1024u;
    const int aoff = lds_byte(wr * 64 + fr, fq * 8), boff = lds_byte(wc * 32 + fr, fq * 8);
#define PG8_SA(b, h) (((b) * 2 + (h)) * HTB)
#define PG8_SB(b, h) ((4 + (b) * 2 + (h)) * HTB)
#define PG8_STAGE(bufoff, gbase, voff) do { _Pragma("unroll") for (int _i = 0; _i < 2; ++_i) \
        __builtin_amdgcn_global_load_lds((const unsigned*)((const char*)(gbase) + (voff)[_i]), (LAS unsigned*)(lds + (bufoff) + ldsw + _i * 8192), 16, 0, 0); } while (0)
#define PG8_LDA(dst, b, h) do { _Pragma("unroll") for (int m = 0; m < 4; ++m) _Pragma("unroll") for (int k = 0; k < 2; ++k) dst[m][k] = *(const LAS bf16x8*)(lds + PG8_SA(b, h) + aoff + m * 2048 + k * 1024); } while (0)
#define PG8_LDB(dst, b, h) do { _Pragma("unroll") for (int n = 0; n < 2; ++n) _Pragma("unroll") for (int k = 0; k < 2; ++k) dst[n][k] = *(const LAS bf16x8*)(lds + PG8_SB(b, h) + boff + n * 2048 + k * 1024); } while (0)
#define PG8_MMA(ai, bj, At, Bt) do { __builtin_amdgcn_s_setprio(1); _Pragma("unroll") for (int m = 0; m < 4; ++m) _Pragma("unroll") for (int n = 0; n < 2; ++n) _Pragma("unroll") for (int k = 0; k < 2; ++k) \
        acc[ai][bj][m][n] = __builtin_amdgcn_mfma_f32_16x16x32_bf16(Bt[n][k], At[m][k], acc[ai][bj][m][n], 0, 0, 0); __builtin_amdgcn_s_setprio(0); } while (0)
#define PG8_WAIT_V(n) asm volatile("s_waitcnt vmcnt(" #n ")" ::: "memory")
#define PG8_WAIT_L(n) asm volatile("s_waitcnt lgkmcnt(" #n ")" ::: "memory")
#define PG8_BAR __builtin_amdgcn_s_barrier()
#define PG8_SCHED __builtin_amdgcn_sched_barrier(0)
    Unit cur, nxt; int ui = 0;
    if (!S.next(0, cur)) return;
    const unsigned stoff = (unsigned)(((lane >> 2) * 16 + (lane & 3) * 4) * 4);
#define PG8_STATS(pm_, buf_) do { if constexpr (Epi::STATS) { const char* sp_ = (const char*)E.ssq + ((size_t)(pm_) * 256 + wid * 32) * 64; \
        __builtin_amdgcn_global_load_lds((const unsigned*)(sp_ + stoff), (LAS unsigned*)(lds + 131072 + (buf_) * 16384 + wid * 2048), 16, 0, 0); \
        __builtin_amdgcn_global_load_lds((const unsigned*)(sp_ + 1024 + stoff), (LAS unsigned*)(lds + 131072 + (buf_) * 16384 + wid * 2048 + 1024), 16, 0, 0); } } while (0)
    PG8_STATS(cur.pm, 0);
    f32x4 acc[2][2][4][2];
#pragma unroll
    for (int a = 0; a < 2; ++a)
#pragma unroll
        for (int b = 0; b < 2; ++b)
#pragma unroll
            for (int m = 0; m < 4; ++m)
#pragma unroll
                for (int n = 0; n < 2; ++n) acc[a][b][m][n] = (f32x4){0.f, 0.f, 0.f, 0.f};
    bf16x8 At[4][2], B0[2][2], B1[2][2];
    const char* cA = (const char*)g.A + (size_t)cur.pm * tstepA; const char* cB = (const char*)g.Bt + (size_t)cur.pn * tstepB;
    PG8_STAGE(PG8_SB(0, 0), cB, voffB); PG8_STAGE(PG8_SB(0, 1), cB + hstepB, voffB); PG8_STAGE(PG8_SA(0, 0), cA, voffA); PG8_STAGE(PG8_SA(0, 1), cA + hstepA, voffA);
    if (wr == 1) PG8_BAR;
    PG8_WAIT_V(2); PG8_BAR;
    PG8_STAGE(PG8_SB(1, 0), cB + kstep, voffB); PG8_STAGE(PG8_SA(1, 0), cA + kstep, voffA); PG8_STAGE(PG8_SB(1, 1), cB + hstepB + kstep, voffB);
    PG8_WAIT_V(6); PG8_BAR;
    for (;;) {
        const bool has_next = S.next(ui + 1, nxt);
        const char* nA = has_next ? (const char*)g.A + (size_t)nxt.pm * tstepA : cA; const char* nB = has_next ? (const char*)g.Bt + (size_t)nxt.pn * tstepB : cB;
        for (int t = 0; t < nt; t += 2) {
            const bool last = (t == nt - 2);
            const char* a1 = cA + (size_t)(t + 1) * kstep;
            const char* a2 = last ? nA : cA + (size_t)(t + 2) * kstep; const char* b2 = last ? nB : cB + (size_t)(t + 2) * kstep;
            const char* a3 = a2 + kstep; const char* b3 = b2 + kstep;
            PG8_LDB(B0, 0, 0); PG8_LDB(B1, 0, 1); PG8_SCHED; PG8_LDA(At, 0, 0); PG8_STAGE(PG8_SA(1, 1), a1 + hstepA, voffA);
            PG8_WAIT_V(8); PG8_WAIT_L(0); PG8_BAR; PG8_MMA(0, 0, At, B0); PG8_MMA(0, 1, At, B1); PG8_BAR; PG8_SCHED;
            PG8_LDA(At, 0, 1); PG8_STAGE(PG8_SB(0, 0), b2, voffB); PG8_STAGE(PG8_SB(0, 1), b2 + hstepB, voffB); PG8_STAGE(PG8_SA(0, 0), a2, voffA);
            PG8_WAIT_V(8); PG8_WAIT_L(0); PG8_BAR; PG8_MMA(1, 0, At, B0); PG8_MMA(1, 1, At, B1); PG8_BAR; PG8_SCHED;
            PG8_LDB(B0, 1, 0); PG8_LDB(B1, 1, 1); PG8_SCHED; PG8_LDA(At, 1, 0); PG8_STAGE(PG8_SA(0, 1), a2 + hstepA, voffA);
            PG8_WAIT_V(8); PG8_WAIT_L(0); PG8_BAR; PG8_MMA(0, 0, At, B0); PG8_MMA(0, 1, At, B1); PG8_BAR; PG8_SCHED;
            PG8_LDA(At, 1, 1); PG8_STAGE(PG8_SB(1, 0), b3, voffB); PG8_STAGE(PG8_SB(1, 1), b3 + hstepB, voffB); PG8_STAGE(PG8_SA(1, 0), a3, voffA);
            PG8_WAIT_V(8); PG8_WAIT_L(0); PG8_BAR; PG8_MMA(1, 0, At, B0); PG8_MMA(1, 1, At, B1); PG8_BAR; PG8_SCHED;
        }
        if (wr == 0) PG8_BAR;
        E(acc, cur, wr, wc, fr, fq, (const LAS float*)(lds + 131072 + (ui & 1) * 16384));
        if (!has_next) break;
#pragma unroll
        for (int a = 0; a < 2; ++a)
#pragma unroll
            for (int b = 0; b < 2; ++b)
#pragma unroll
                for (int m = 0; m < 4; ++m)
#pragma unroll
                    for (int n = 0; n < 2; ++n) acc[a][b][m][n] = (f32x4){0.f, 0.f, 0.f, 0.f};
        cur = nxt; cA = nA; cB = nB; ++ui;
        PG8_STATS(cur.pm, ui & 1);
        if (wr == 1) PG8_BAR;
    }
    PG8_WAIT_V(0);
    PG8_BAR;
#undef PG8_STATS
#undef PG8_SA
#undef PG8_SB
#undef PG8_STAGE
#undef PG8_LDA
#undef PG8_LDB
#undef PG8_MMA
#undef PG8_WAIT_V
#undef PG8_WAIT_L
#undef PG8_BAR
#undef PG8_SCHED
}
}

struct EpiInProj {
    static constexpr bool STATS = true;
    bf16_t* O; const float* ssq; const f32x2* rope;
    __device__ __forceinline__ void operator()(const f32x4 (&acc)[2][2][4][2], const pg8::Unit& u, int wr, int wc, int fr, int fq, const LAS float* stats) const {
        const int pn = u.pn; const bool rot = (pn == 2 || pn == 3 || pn == 8 || pn == 9); const float qs = pn < 4 ? QSCALE : 1.0f;
        const int rl0 = wr * 64 + fr, row0 = u.pm * 256 + rl0;
        const int cin = wc * 32 + 8 * fq;
#pragma unroll
        for (int ai = 0; ai < 2; ++ai) {
#pragma unroll
          for (int mp = 0; mp < 2; ++mp) {
            f32x4 rc[4][2][2];
            if (rot) {
#pragma unroll
                for (int m = 2 * mp; m < 2 * mp + 2; ++m) { const int t = tok_pos(row0 + ai * 128 + m * 16);
#pragma unroll
                    for (int bj = 0; bj < 2; ++bj) { const f32x4* rp = (const f32x4*)(rope + (size_t)t * 32 + (((bj * 128 + cin) & 63) >> 1)); rc[m][bj][0] = rp[0]; rc[m][bj][1] = rp[1]; } }
            }
#pragma unroll
            for (int m = 2 * mp; m < 2 * mp + 2; ++m) {
                const int row = row0 + ai * 128 + m * 16; const float rs = rstd_lds(stats, rl0 + ai * 128 + m * 16) * qs;
#pragma unroll
                for (int bj = 0; bj < 2; ++bj) {
                    const int col0 = pn * 256 + bj * 128 + cin;
                    f32x4 v0 = acc[ai][bj][m][0] * rs, v1 = acc[ai][bj][m][1] * rs;
                    if (rot) {
                        const f32x4 c0 = rc[m][bj][0], c1 = rc[m][bj][1];
                        f32x4 w0, w1;
                        w0[0] = v0[0] * c0[0] - v0[1] * c0[1]; w0[1] = v0[1] * c0[0] + v0[0] * c0[1];
                        w0[2] = v0[2] * c0[2] - v0[3] * c0[3]; w0[3] = v0[3] * c0[2] + v0[2] * c0[3];
                        w1[0] = v1[0] * c1[0] - v1[1] * c1[1]; w1[1] = v1[1] * c1[0] + v1[0] * c1[1];
                        w1[2] = v1[2] * c1[2] - v1[3] * c1[3]; w1[3] = v1[3] * c1[2] + v1[2] * c1[3];
                        v0 = w0; v1 = w1;
                    }
                    u32x4 w; w.x = cvt_pk_bf16(v0[0], v0[1]); w.y = cvt_pk_bf16(v0[2], v0[3]); w.z = cvt_pk_bf16(v1[0], v1[1]); w.w = cvt_pk_bf16(v1[2], v1[3]);
                    *(u32x4*)(O + (size_t)row * NQKV + col0) = w;
                }
            }
            __builtin_amdgcn_sched_barrier(0);
          }
        }
    }
};
struct EpiResid {
    static constexpr bool STATS = false;
    bf16_t* XB; float* ssq_next;
    __device__ __forceinline__ void operator()(const f32x4 (&acc)[2][2][4][2], const pg8::Unit& u, int wr, int wc, int fr, int fq, const LAS float*) const {
        const int row0 = u.pm * 256 + wr * 64 + fr; const int colb = u.pn * 256 + wc * 32 + 8 * fq;
#pragma unroll
        for (int ai = 0; ai < 2; ++ai) {
            u32x4 xo[4][2];
#pragma unroll
            for (int m = 0; m < 4; ++m)
#pragma unroll
                for (int bj = 0; bj < 2; ++bj) xo[m][bj] = *(const u32x4*)(XB + (size_t)(row0 + ai * 128 + m * 16) * DM + colb + bj * 128);
#pragma unroll
            for (int m = 0; m < 4; ++m) {
                const int row = row0 + ai * 128 + m * 16; float s = 0.f;
#pragma unroll
                for (int bj = 0; bj < 2; ++bj) {
                    const u32x4 o = xo[m][bj]; const f32x4 a0 = acc[ai][bj][m][0], a1 = acc[ai][bj][m][1];
                    u32x4 w;
                    w.x = cvt_pk_bf16(__uint_as_float(o.x << 16) + a0[0], __uint_as_float(o.x & 0xffff0000u) + a0[1]);
                    w.y = cvt_pk_bf16(__uint_as_float(o.y << 16) + a0[2], __uint_as_float(o.y & 0xffff0000u) + a0[3]);
                    w.z = cvt_pk_bf16(__uint_as_float(o.z << 16) + a1[0], __uint_as_float(o.z & 0xffff0000u) + a1[1]);
                    w.w = cvt_pk_bf16(__uint_as_float(o.w << 16) + a1[2], __uint_as_float(o.w & 0xffff0000u) + a1[3]);
                    *(u32x4*)(XB + (size_t)row * DM + colb + bj * 128) = w;
                    const float r0 = __uint_as_float(w.x << 16), r1 = __uint_as_float(w.x & 0xffff0000u), r2 = __uint_as_float(w.y << 16), r3 = __uint_as_float(w.y & 0xffff0000u);
                    const float r4 = __uint_as_float(w.z << 16), r5 = __uint_as_float(w.z & 0xffff0000u), r6 = __uint_as_float(w.w << 16), r7 = __uint_as_float(w.w & 0xffff0000u);
                    s += ((r0 * r0 + r1 * r1) + (r2 * r2 + r3 * r3)) + ((r4 * r4 + r5 * r5) + (r6 * r6 + r7 * r7));
                }
                s += swz_xor<16>(s);
                { auto rr = __builtin_amdgcn_permlane32_swap(__float_as_uint(s), __float_as_uint(s), false, false); s = __uint_as_float(rr[0]) + __uint_as_float(rr[1]); }
                if (fq == 0) ssq_next[(size_t)row * 16 + u.pn * 4 + wc] = s;
            }
        }
    }
};
struct EpiUp {
    static constexpr bool STATS = true;
    bf16_t* H; float* HB; const float* ssq; const float* cw; const float* cb;
    __device__ __forceinline__ void operator()(const f32x4 (&acc)[2][2][4][2], const pg8::Unit& u, int wr, int wc, int fr, int fq, const LAS float* stats) const {
        const int ffc0 = u.pn * 128 + wc * 32 + 8 * fq;
        const unsigned long long is0 = __ballot(fr == 0), is15 = __ballot(fr == 15);
#pragma unroll
        for (int ai = 0; ai < 2; ++ai) {
            const int rowbase = u.pm * 256 + ai * 128 + wr * 64; const int grp = rowbase >> 6;
            float rs[4];
#pragma unroll
            for (int m = 0; m < 4; ++m) rs[m] = rstd_lds(stats, ai * 128 + wr * 64 + 16 * m + fr);
            u32x2 keep[4];
#pragma unroll
            for (int n = 0; n < 2; ++n) {
                const f32x4 w0 = *(const f32x4*)(cw + ffc0 + 4 * n), w1 = *(const f32x4*)(cw + DFF + ffc0 + 4 * n), w2 = *(const f32x4*)(cw + 2 * DFF + ffc0 + 4 * n), bb = *(const f32x4*)(cb + ffc0 + 4 * n);
                f32x4 g[4], R[4], Lr[4], up4[4], dn4[4];
#pragma unroll
                for (int m = 0; m < 4; ++m) { g[m] = acc[ai][0][m][n] * rs[m];
#pragma unroll
                    for (int e = 0; e < 4; ++e) { R[m][e] = __int_as_float(__builtin_amdgcn_update_dpp(0, __float_as_int(g[m][e]), 0x121, 0xf, 0xf, false));
                        Lr[m][e] = __int_as_float(__builtin_amdgcn_update_dpp(0, __float_as_int(g[m][e]), 0x12F, 0xf, 0xf, false)); } }
#pragma unroll
                for (int m = 0; m < 4; ++m)
#pragma unroll
                    for (int e = 0; e < 4; ++e) {
                        float a = R[m][e], b = R[m > 0 ? m - 1 : 0][e], c = Lr[m][e], d = Lr[m < 3 ? m + 1 : 3][e];
                        asm volatile("v_cndmask_b32 %0, %1, %2, %3" : "=v"(up4[m][e]) : "v"(a), "v"(b), "s"(is0));
                        asm volatile("v_cndmask_b32 %0, %1, %2, %3" : "=v"(dn4[m][e]) : "v"(c), "v"(d), "s"(is15));
                    }
#pragma unroll
                for (int m = 0; m < 4; ++m) {
                    const f32x4 v = acc[ai][1][m][n] * rs[m];
                    const f32x4 up = up4[m];
                    const f32x4 dn = dn4[m];
                    const bool first = (m == 0) && (fr == 0), last = (m == 3) && (fr == 15);
                    f32x4 x = w1 * g[m] + bb;
                    if (!first) x += w0 * up;
                    if (!last) x += w2 * dn;
                    if (first || last) {
                        float* hb = HB + (size_t)((grp * 2 + (last ? 1 : 0)) * 3) * DFF + ffc0 + 4 * n;
                        *(f32x4*)hb = x; *(f32x4*)(hb + DFF) = v; *(f32x4*)(hb + 2 * DFF) = g[m];
                    } else {
                        const f32x4 hv = gelu4(x) * v;
                        u32x2 w; w.x = cvt_pk_bf16(hv[0], hv[1]); w.y = cvt_pk_bf16(hv[2], hv[3]);
                        if (n == 0) keep[m] = w;
                        else { u32x4 w4; w4.x = keep[m].x; w4.y = keep[m].y; w4.z = w.x; w4.w = w.y; *(u32x4*)(H + (size_t)(rowbase + 16 * m + fr) * DFF + ffc0) = w4; }
                    }
                }
                __builtin_amdgcn_sched_barrier(0);
            }
        }
    }
};

namespace att {
constexpr float THRL = 10.f;
#define KSWZ(row, colB) ((row) * 256 + ((colB) ^ (((row) & 15) << 4)))
#define SBAR() __builtin_amdgcn_sched_barrier(0)
__device__ __forceinline__ int crow(int r, int hi) { return (r & 3) + 8 * (r >> 2) + 4 * hi; }
__device__ __forceinline__ void softmax_tile(f32x16& p0, f32x16& p1, float& m_reg, float& l_reg, float& alpha, bf16x8& pa0, bf16x8& pa1, bf16x8& pa2, bf16x8& pa3) {
    float pmax = p0[0];
#pragma unroll
    for (int r = 1; r < 16; ++r) pmax = fmaxf(pmax, p0[r]);
#pragma unroll
    for (int r = 0; r < 16; ++r) pmax = fmaxf(pmax, p1[r]);
    { auto rr = __builtin_amdgcn_permlane32_swap(__float_as_uint(pmax), __float_as_uint(pmax), false, false);
      pmax = fmaxf(__uint_as_float(rr[0]), __uint_as_float(rr[1])); }
    float mn;
    if (__builtin_expect(__all(pmax - m_reg <= THRL), 1)) { mn = m_reg; alpha = 1.f; }
    else { mn = fmaxf(m_reg, pmax); alpha = __builtin_amdgcn_exp2f(m_reg - mn); m_reg = mn; }
#pragma unroll
    for (int r = 0; r < 16; ++r) p0[r] = __builtin_amdgcn_exp2f(p0[r] - mn);
#pragma unroll
    for (int r = 0; r < 16; ++r) p1[r] = __builtin_amdgcn_exp2f(p1[r] - mn);
    float ps = 0;
#pragma unroll
    for (int r = 0; r < 16; ++r) ps += p0[r];
#pragma unroll
    for (int r = 0; r < 16; ++r) ps += p1[r];
    { auto rr = __builtin_amdgcn_permlane32_swap(__float_as_uint(ps), __float_as_uint(ps), false, false);
      ps = __uint_as_float(rr[0]) + __uint_as_float(rr[1]); }
    l_reg = l_reg * alpha + ps;
#define PK4(P, BASE, OUT) do { unsigned a0 = cvt_pk_bf16(P[BASE + 0], P[BASE + 1]), a1 = cvt_pk_bf16(P[BASE + 2], P[BASE + 3]);   \
    unsigned b0 = cvt_pk_bf16(P[BASE + 4], P[BASE + 5]), b1 = cvt_pk_bf16(P[BASE + 6], P[BASE + 7]);                              \
    auto r0 = __builtin_amdgcn_permlane32_swap(a0, b0, false, false); auto r1 = __builtin_amdgcn_permlane32_swap(a1, b1, false, false); \
    u32x4 w = {r0[0], r1[0], r0[1], r1[1]}; OUT = __builtin_bit_cast(bf16x8, w); } while (0)
    PK4(p0, 0, pa0); PK4(p0, 8, pa1); PK4(p1, 0, pa2); PK4(p1, 8, pa3);
#undef PK4
}
__device__ __forceinline__ void qkt4(f32x16& p0, f32x16& p1, const LAS unsigned char* Ks, const bf16x8* qr, int dc0, int r32, int hi) {
    p0 = f32x16{}; p1 = f32x16{};
#pragma unroll
    for (int d0 = 0; d0 < 4; ++d0) { const int cb = ((dc0 + d0) * 16 + hi * 8) * 2;
        const bf16x8 b0 = *(const LAS bf16x8*)(Ks + KSWZ(r32, cb));
        const bf16x8 b1 = *(const LAS bf16x8*)(Ks + KSWZ(32 + r32, cb));
        p0 = __builtin_amdgcn_mfma_f32_32x32x16_bf16(b0, qr[d0], p0, 0, 0, 0);
        p1 = __builtin_amdgcn_mfma_f32_32x32x16_bf16(b1, qr[d0], p1, 0, 0, 0); }
}
__device__ __forceinline__ int v_rd_base(int lane) { return ((lane & 3) << 3) | (((lane >> 2) & 3) << 6) | (((lane >> 4) & 1) << 5) | (((lane >> 5) & 1) << 8); }
constexpr int v_rd_off(int d0, int ks, int half) { return d0 * 512 + ks * 4096 + half * 2048; }
template <int OFF> __device__ __forceinline__ s16x4 tr_read(int vb) {
    s16x4 r; asm volatile("ds_read_b64_tr_b16 %0, %1 offset:%2" : "=&v"(r) : "v"(vb), "i"(OFF) : "memory"); return r;
}
#define PKV(L, H) (bf16x8){L[0], L[1], L[2], L[3], H[0], H[1], H[2], H[3]}
template <int D0> __device__ __forceinline__ void pv_two(f32x16& oa, f32x16& ob, int vb, const bf16x8 (&pa)[4], const bf16x8 (&pb)[4]) {
    const s16x4 l0 = tr_read<v_rd_off(D0, 0, 0)>(vb), h0 = tr_read<v_rd_off(D0, 0, 1)>(vb), l1 = tr_read<v_rd_off(D0, 1, 0)>(vb), h1 = tr_read<v_rd_off(D0, 1, 1)>(vb);
    const s16x4 l2 = tr_read<v_rd_off(D0, 2, 0)>(vb), h2 = tr_read<v_rd_off(D0, 2, 1)>(vb), l3 = tr_read<v_rd_off(D0, 3, 0)>(vb), h3 = tr_read<v_rd_off(D0, 3, 1)>(vb);
    asm volatile("s_waitcnt lgkmcnt(0)" ::: "memory"); SBAR();
    oa = __builtin_amdgcn_mfma_f32_32x32x16_bf16(pa[0], PKV(l0, h0), oa, 0, 0, 0); ob = __builtin_amdgcn_mfma_f32_32x32x16_bf16(pb[0], PKV(l0, h0), ob, 0, 0, 0);
    oa = __builtin_amdgcn_mfma_f32_32x32x16_bf16(pa[1], PKV(l1, h1), oa, 0, 0, 0); ob = __builtin_amdgcn_mfma_f32_32x32x16_bf16(pb[1], PKV(l1, h1), ob, 0, 0, 0);
    oa = __builtin_amdgcn_mfma_f32_32x32x16_bf16(pa[2], PKV(l2, h2), oa, 0, 0, 0); ob = __builtin_amdgcn_mfma_f32_32x32x16_bf16(pb[2], PKV(l2, h2), ob, 0, 0, 0);
    oa = __builtin_amdgcn_mfma_f32_32x32x16_bf16(pa[3], PKV(l3, h3), oa, 0, 0, 0); ob = __builtin_amdgcn_mfma_f32_32x32x16_bf16(pb[3], PKV(l3, h3), ob, 0, 0, 0);
}
template <int D0> __device__ __forceinline__ void pv_one(f32x16& oa, int vb, const bf16x8 (&pa)[4]) {
    const s16x4 l0 = tr_read<v_rd_off(D0, 0, 0)>(vb), h0 = tr_read<v_rd_off(D0, 0, 1)>(vb), l1 = tr_read<v_rd_off(D0, 1, 0)>(vb), h1 = tr_read<v_rd_off(D0, 1, 1)>(vb);
    const s16x4 l2 = tr_read<v_rd_off(D0, 2, 0)>(vb), h2 = tr_read<v_rd_off(D0, 2, 1)>(vb), l3 = tr_read<v_rd_off(D0, 3, 0)>(vb), h3 = tr_read<v_rd_off(D0, 3, 1)>(vb);
    asm volatile("s_waitcnt lgkmcnt(0)" ::: "memory"); SBAR();
    oa = __builtin_amdgcn_mfma_f32_32x32x16_bf16(pa[0], PKV(l0, h0), oa, 0, 0, 0);
    oa = __builtin_amdgcn_mfma_f32_32x32x16_bf16(pa[1], PKV(l1, h1), oa, 0, 0, 0);
    oa = __builtin_amdgcn_mfma_f32_32x32x16_bf16(pa[2], PKV(l2, h2), oa, 0, 0, 0);
    oa = __builtin_amdgcn_mfma_f32_32x32x16_bf16(pa[3], PKV(l3, h3), oa, 0, 0, 0);
}
template <int HALF>
__device__ __forceinline__ void na_tile(f32x16& p0, f32x16& p1, const LAS float* bl, int relb, float& m_reg, float& l_reg, float& alpha, bf16x8 (&pa)[3]) {
    f32x16& F = HALF ? p1 : p0; f32x16& S = HALF ? p0 : p1;
    constexpr int SB = HALF ? 12 : 0, FT = HALF ? 32 : 0, ST = HALF ? 0 : 32;
#pragma unroll
    for (int rr = 0; rr < 16; ++rr) { const int kc = FT + (rr & 3) + 8 * (rr >> 2); const float b = bl[kc]; const bool ok = (unsigned)(kc + relb) < 16u; F[rr] = ok ? F[rr] + b : -INFINITY; }
#pragma unroll
    for (int i = 0; i < 4; ++i) { const int rr = SB + i; const int kc = ST + (rr & 3) + 8 * (rr >> 2); const float b = bl[kc]; const bool ok = (unsigned)(kc + relb) < 16u; S[rr] = ok ? S[rr] + b : -INFINITY; }
    float pmax = F[0];
#pragma unroll
    for (int r = 1; r < 16; ++r) pmax = fmaxf(pmax, F[r]);
#pragma unroll
    for (int i = 0; i < 4; ++i) pmax = fmaxf(pmax, S[SB + i]);
    { auto rr = __builtin_amdgcn_permlane32_swap(__float_as_uint(pmax), __float_as_uint(pmax), false, false);
      pmax = fmaxf(__uint_as_float(rr[0]), __uint_as_float(rr[1])); }
    float mn;
    if (__builtin_expect(__all(pmax - m_reg <= THRL), 1)) { mn = m_reg; alpha = 1.f; }
    else { mn = fmaxf(m_reg, pmax); alpha = __builtin_amdgcn_exp2f(m_reg - mn); m_reg = mn; }
    float ps = 0;
#pragma unroll
    for (int r = 0; r < 16; ++r) { F[r] = __builtin_amdgcn_exp2f(F[r] - mn); ps += F[r]; }
#pragma unroll
    for (int i = 0; i < 4; ++i) { S[SB + i] = __builtin_amdgcn_exp2f(S[SB + i] - mn); ps += S[SB + i]; S[(SB ^ 4) + i] = 0.f; }
    { auto rr = __builtin_amdgcn_permlane32_swap(__float_as_uint(ps), __float_as_uint(ps), false, false);
      ps = __uint_as_float(rr[0]) + __uint_as_float(rr[1]); }
    l_reg = l_reg * alpha + ps;
#define PK4(P, BASE, OUT) do { unsigned a0 = cvt_pk_bf16(P[BASE + 0], P[BASE + 1]), a1 = cvt_pk_bf16(P[BASE + 2], P[BASE + 3]);   \
    unsigned b0 = cvt_pk_bf16(P[BASE + 4], P[BASE + 5]), b1 = cvt_pk_bf16(P[BASE + 6], P[BASE + 7]);                              \
    auto r0 = __builtin_amdgcn_permlane32_swap(a0, b0, false, false); auto r1 = __builtin_amdgcn_permlane32_swap(a1, b1, false, false); \
    u32x4 w = {r0[0], r1[0], r0[1], r1[1]}; OUT = __builtin_bit_cast(bf16x8, w); } while (0)
    PK4(F, 0, pa[0]); PK4(F, 8, pa[1]); PK4(S, (SB & 8), pa[2]);
#undef PK4
}
template <int D0, int KA, int KB, int KC> __device__ __forceinline__ void pv_three(f32x16& oa, int vb, const bf16x8 (&pa)[3]) {
    const s16x4 l0 = tr_read<v_rd_off(D0, KA, 0)>(vb), h0 = tr_read<v_rd_off(D0, KA, 1)>(vb), l1 = tr_read<v_rd_off(D0, KB, 0)>(vb), h1 = tr_read<v_rd_off(D0, KB, 1)>(vb);
    const s16x4 l2 = tr_read<v_rd_off(D0, KC, 0)>(vb), h2 = tr_read<v_rd_off(D0, KC, 1)>(vb);
    asm volatile("s_waitcnt lgkmcnt(0)" ::: "memory"); SBAR();
    oa = __builtin_amdgcn_mfma_f32_32x32x16_bf16(pa[0], PKV(l0, h0), oa, 0, 0, 0);
    oa = __builtin_amdgcn_mfma_f32_32x32x16_bf16(pa[1], PKV(l1, h1), oa, 0, 0, 0);
    oa = __builtin_amdgcn_mfma_f32_32x32x16_bf16(pa[2], PKV(l2, h2), oa, 0, 0, 0);
}
__device__ __forceinline__ void dma_offsets(int wid, int lane, unsigned (&ko)[2], unsigned (&vo)[2]) {
#pragma unroll
    for (int p = 0; p < 2; ++p) { const int pc = wid * 2 + p;
        { const int row = pc * 4 + (lane >> 4), ch = (lane & 15) ^ (row & 15); ko[p] = (unsigned)(row * NQKV + ch * 8) * 2u; }
        { const int s = pc * 64 + lane, st = s >> 5, wi = s & 31, kk = (st >> 2) * 8 + (wi >> 2), k = (kk & ~0xC) | ((kk & 4) << 1) | ((kk & 8) >> 1), c = (st & 3) * 32 + (wi & 3) * 8;
          vo[p] = (unsigned)(k * NQKV + c) * 2u; } }
}
__device__ __forceinline__ void dma_issue(const char* Kg, const char* Vg, const unsigned (&ko)[2], const unsigned (&vo)[2], LAS unsigned char* L, int kbuf, int vbuf, int wid) {
#pragma unroll
    for (int p = 0; p < 2; ++p) {
        __builtin_amdgcn_global_load_lds((const unsigned*)(Kg + ko[p]), (LAS unsigned*)(L + A_OFF_K + kbuf * 16384 + (wid * 2 + p) * 1024), 16, 0, 0);
        __builtin_amdgcn_global_load_lds((const unsigned*)(Vg + vo[p]), (LAS unsigned*)(L + A_OFF_V + vbuf * 16384 + (wid * 2 + p) * 1024), 16, 0, 0);
    }
}
#define TILE_SYNC() do { asm volatile("s_waitcnt vmcnt(0)" ::: "memory"); __syncthreads(); } while (0)
#define RESC1(o, nb, a) do { if (__any((a) < 1.f)) { if (hi == 0) al_l[r32] = (a); asm volatile("s_waitcnt lgkmcnt(0)" ::: "memory"); \
    _Pragma("unroll") for (int d_ = 0; d_ < nb; ++d_) _Pragma("unroll") for (int r_ = 0; r_ < 16; ++r_) o[d_][r_] *= al_l[crow(r_, hi)]; \
    asm volatile("s_waitcnt lgkmcnt(0)" ::: "memory"); } } while (0)

__device__ __forceinline__ void diff_unit(bf16_t* QKV, int row0, int T, int q0, int h, float lam, float oscale, const float* subg, LAS unsigned char* L, int wave_s) {
    const int tid = opaque_tid(wave_s), wid = __builtin_amdgcn_readfirstlane(tid >> 6), lane = tid & 63, r32 = lane & 31, hi = lane >> 5;
    LAS float* al_l = (LAS float*)(L + A_OFF_WS) + wid * 64; LAS float* li_l = al_l + 32;
    const int qrow0 = row0 + q0 + wid * 32;
    LAS unsigned char* Qs = L + A_OFF_Q + wid * 8704 + r32 * 272 + hi * 16;
    bf16x8 q1r[4];
    { const bf16_t* Qw = QKV + (size_t)(qrow0 + r32) * NQKV + C_QB + h * 128 + hi * 8;
#pragma unroll
      for (int d0 = 0; d0 < 4; ++d0) q1r[d0] = *(const bf16x8*)(Qw + d0 * 16);
#pragma unroll
      for (int d0 = 4; d0 < 8; ++d0) *(LAS bf16x8*)(Qs + d0 * 32) = *(const bf16x8*)(Qw + d0 * 16); }
    const char* Kg = (const char*)(QKV + (size_t)row0 * NQKV + C_KB + h * 128);
    const char* Vg = (const char*)(QKV + (size_t)row0 * NQKV + C_VB + h * 128);
    const int vb0 = (int)(unsigned)(uintptr_t)(L + A_OFF_V) + v_rd_base(lane);
    const size_t tstep = (size_t)64 * NQKV * 2;
    const int NT = T / 64;
    f32x16 o1[4] = {}, o2[4] = {};
    float m1 = -1e30f, m2 = -1e30f, l1 = 0.f, l2 = 0.f;
    const int trailing = wid >> 2;
    unsigned go[2];
    { unsigned ko4[2], vo4[2];
      dma_offsets((wid & 3) * 2, lane, ko4, vo4); go[0] = trailing ? vo4[0] : ko4[0]; go[1] = trailing ? vo4[1] : ko4[1]; }
    const unsigned go23 = (trailing ? 4u : 8u) * (unsigned)(NQKV * 2), gox = trailing ? 0u : 0x80u;
    const char* Gsrc = trailing ? Vg : Kg;
    const int gdst = (trailing ? A_OFF_V : A_OFF_K) + (wid & 3) * 4096;
#define DIFF_DMA(t) do { const char* gs_ = Gsrc + (size_t)(t) * tstep; const int gd_ = gdst + ((t) & 1) * 16384; \
        _Pragma("unroll") for (int p_ = 0; p_ < 4; ++p_) __builtin_amdgcn_global_load_lds((const unsigned*)(gs_ + ((p_ >> 1) ? (go[p_ & 1] ^ gox) + go23 : go[p_ & 1])), (LAS unsigned*)(L + gd_ + p_ * 1024), 16, 0, 0); } while (0)
    DIFF_DMA(0); TILE_SYNC();
    if (trailing) __builtin_amdgcn_s_barrier();
#pragma unroll 1
    for (int t = 0; t < NT; ++t) {
        bf16x8 pa[4], pb[4]; f32x16 p0, p1; float al1, al2;
        if (t + 1 < NT) DIFF_DMA(t + 1);
        { const LAS unsigned char* Ks = L + A_OFF_K + (t & 1) * 16384; bf16x8 qr[4];
          qkt4(p0, p1, Ks, q1r, 0, r32, hi);
          softmax_tile(p0, p1, m1, l1, al1, pa[0], pa[1], pa[2], pa[3]);
#pragma unroll
          for (int d0 = 0; d0 < 4; ++d0) qr[d0] = *(const LAS bf16x8*)(Qs + (d0 + 4) * 32);
          qkt4(p0, p1, Ks, qr, 4, r32, hi); }
        asm volatile("s_waitcnt lgkmcnt(0)" ::: "memory"); __builtin_amdgcn_s_barrier(); asm volatile("" ::: "memory");
        softmax_tile(p0, p1, m2, l2, al2, pb[0], pb[1], pb[2], pb[3]);
        RESC1(o1, 4, al1); RESC1(o2, 4, al2);
        { const int vb = vb0 + (t & 1) * 16384;
          pv_two<0>(o1[0], o2[0], vb, pa, pb); pv_two<1>(o1[1], o2[1], vb, pa, pb); pv_two<2>(o1[2], o2[2], vb, pa, pb); pv_two<3>(o1[3], o2[3], vb, pa, pb); }
        asm volatile("s_waitcnt vmcnt(0) lgkmcnt(0)" ::: "memory"); __builtin_amdgcn_s_barrier(); asm volatile("" ::: "memory");
    }
    if (!trailing) __builtin_amdgcn_s_barrier();
#undef DIFF_DMA
    if (hi == 0) { al_l[r32] = l1; li_l[r32] = l2; } asm volatile("s_waitcnt lgkmcnt(0)" ::: "memory");
    float gsc[4];
#pragma unroll
    for (int d0 = 0; d0 < 4; ++d0) gsc[d0] = subg[d0 * 32 + r32] * oscale;
    bf16_t* Ow = QKV + (size_t)qrow0 * NQKV + C_QB + h * 128 + r32;
#pragma unroll
    for (int r = 0; r < 16; ++r) {
        const int orow = crow(r, hi);
        const float r1 = __builtin_amdgcn_rcpf(al_l[orow]), r2 = lam * __builtin_amdgcn_rcpf(li_l[orow]);
        float v[4]; float ss = 0.f;
#pragma unroll
        for (int d0 = 0; d0 < 4; ++d0) { v[d0] = o1[d0][r] * r1 - o2[d0][r] * r2; ss += v[d0] * v[d0]; }
        ss += swz_xor<1>(ss); ss += swz_xor<2>(ss); ss += swz_xor<4>(ss); ss += swz_xor<8>(ss); ss += swz_xor<16>(ss);
        const float rn = __builtin_amdgcn_rsqf(ss * (1.0f / 128.0f) + EPS);
#pragma unroll
        for (int d0 = 0; d0 < 4; ++d0) { const float y = v[d0] * rn * gsc[d0]; Ow[(size_t)orow * NQKV + d0 * 32] = (bf16_t)(cvt_pk_bf16(y, y) & 0xffffu); }
    }
    asm volatile("s_waitcnt lgkmcnt(0)" ::: "memory");
}

__device__ __forceinline__ void na_unit(bf16_t* QKV, int row0, int R, int rp, int hp, const float* rpb, LAS unsigned char* L, int wave_s) {
    const int tid = opaque_tid(wave_s), wid = __builtin_amdgcn_readfirstlane(tid >> 6), lane = tid & 63, r32 = lane & 31, hi = lane >> 5;
    constexpr int N_OFF_WS = 98304, N_OFF_BIAS = 100352;
    LAS float* al_l = (LAS float*)(L + N_OFF_WS) + wid * 64; LAS float* li_l = al_l + 32;
    LAS float* bias = (LAS float*)(L + N_OFF_BIAS);
    for (int i = tid; i < 2 * 15 * 31; i += 512) bias[i] = rpb[hp * 2 * 15 * 31 + i] * LOG2E;
    const int qrow = wid >> 2, head = (wid >> 1) & 1, half = wid & 1, hh = hp * 2 + head;
    const int r = 2 * rp + qrow;
    const int st = min(max(r - 4, 0), R - 8);
    const int kr_lo = min(max(2 * rp - 4, 0), R - 8), kr_hi = min(max(2 * rp + 1 - 4, 0), R - 8) + 7;
    const int tok0 = row0 + r * 64 + half * 32;
    bf16x8 qr[4];
    { const bf16_t* Qw = QKV + (size_t)(tok0 + r32) * NQKV + C_QA + hh * 64 + hi * 8;
#pragma unroll
      for (int d0 = 0; d0 < 4; ++d0) qr[d0] = *(const bf16x8*)(Qw + d0 * 16); }
    const char* Kg = (const char*)(QKV + (size_t)row0 * NQKV + C_KA + hp * 128);
    const char* Vg = (const char*)(QKV + (size_t)row0 * NQKV + C_VA + hp * 128);
    unsigned ko[2], vo[2]; dma_offsets(wid, lane, ko, vo);
    const int vb0 = (int)(unsigned)(uintptr_t)(L + A_OFF_V) + v_rd_base(lane);
    const size_t tstep = (size_t)64 * NQKV * 2;
    const int c = half * 32 + r32, cs = min(max(c - 8, 0), 48);
    f32x16 o[2] = {};
    float m_reg = -1e30f, l_reg = 0.f;
    dma_issue(Kg + (size_t)kr_lo * tstep, Vg + (size_t)kr_lo * tstep, ko, vo, L, 0, 0, wid);
    dma_issue(Kg + (size_t)(kr_lo + 1) * tstep, Vg + (size_t)(kr_lo + 1) * tstep, ko, vo, L, 1, 1, wid);
    asm volatile("s_waitcnt vmcnt(4) lgkmcnt(0)" ::: "memory"); __builtin_amdgcn_s_barrier(); asm volatile("" ::: "memory");
    int cur = 0, nx2 = 2;
#pragma unroll 1
    for (int kr = kr_lo; kr <= kr_hi; ++kr) {
        if (kr + 2 <= kr_hi) dma_issue(Kg + (size_t)(kr + 2) * tstep, Vg + (size_t)(kr + 2) * tstep, ko, vo, L, nx2, nx2, wid);
        if (kr >= st && kr < st + 8) {
            const LAS unsigned char* Ks = L + A_OFF_K + cur * 16384;
            f32x16 p0, p1; bf16x8 pa[3]; float al;
            qkt4(p0, p1, Ks, qr, head * 4, r32, hi);
            const int dr = kr - r + 7;
            const LAS float* bl = bias + (head * 15 + dr) * 31 + (4 * hi - c + 15);
            const int relb = 4 * hi - cs;
            const int vb = vb0 + cur * 16384;
            if (half == 0) {
                na_tile<0>(p0, p1, bl, relb, m_reg, l_reg, al, pa);
                RESC1(o, 2, al);
                if (head == 0) { pv_three<0, 0, 1, 2>(o[0], vb, pa); pv_three<1, 0, 1, 2>(o[1], vb, pa); } else { pv_three<2, 0, 1, 2>(o[0], vb, pa); pv_three<3, 0, 1, 2>(o[1], vb, pa); }
            } else {
                na_tile<1>(p0, p1, bl, relb, m_reg, l_reg, al, pa);
                RESC1(o, 2, al);
                if (head == 0) { pv_three<0, 2, 3, 1>(o[0], vb, pa); pv_three<1, 2, 3, 1>(o[1], vb, pa); } else { pv_three<2, 2, 3, 1>(o[0], vb, pa); pv_three<3, 2, 3, 1>(o[1], vb, pa); }
            }
        }
        if (kr + 2 <= kr_hi) asm volatile("s_waitcnt vmcnt(4) lgkmcnt(0)" ::: "memory"); else asm volatile("s_waitcnt vmcnt(0) lgkmcnt(0)" ::: "memory");
        __builtin_amdgcn_s_barrier(); asm volatile("" ::: "memory");
        cur = (cur == 2) ? 0 : cur + 1; nx2 = (nx2 == 2) ? 0 : nx2 + 1;
    }
    if (hi == 0) li_l[r32] = l_reg; asm volatile("s_waitcnt lgkmcnt(0)" ::: "memory");
    bf16_t* Ow = QKV + (size_t)tok0 * NQKV + C_QA + hh * 64 + r32;
#pragma unroll
    for (int rr = 0; rr < 16; ++rr) { const int orow = crow(rr, hi); const float rl = __builtin_amdgcn_rcpf(li_l[orow]);
#pragma unroll
        for (int d0 = 0; d0 < 2; ++d0) { const float y = o[d0][rr] * rl; Ow[(size_t)orow * NQKV + d0 * 32] = (bf16_t)(cvt_pk_bf16(y, y) & 0xffffu); } }
    asm volatile("s_waitcnt lgkmcnt(0)" ::: "memory");
}
}

#define XB_TMO      128
#define XB_XCNT(j)  (256  + 64 * (j))
#define XB_XSUB(j)  (1280 + 64 * (j))
#define XB_XGEN(j)  (2304 + 64 * (j))
#define XB_TOP      3328
#define XB_TOPGEN   3392
#define XB_SPIN_CAP (1u << 22)
__device__ __forceinline__ unsigned xb_ld(unsigned* p)              { return __hip_atomic_load(p, __ATOMIC_RELAXED, __HIP_MEMORY_SCOPE_AGENT); }
__device__ __forceinline__ unsigned xb_add(unsigned* p, unsigned v) { return __hip_atomic_fetch_add(p, v, __ATOMIC_RELAXED, __HIP_MEMORY_SCOPE_AGENT); }
__device__ __forceinline__ unsigned xb_xcc_id() { return (unsigned)__builtin_amdgcn_s_getreg((3 << 11) | 20) & 0xFu; }
#define XB_SPIN(cond, bar) do { unsigned _sp = 0; while (cond) { __builtin_amdgcn_s_sleep(1); \
    if ((++_sp & 255u) == 0u) { if (xb_ld(&(bar)[XB_TMO])) break; if (_sp > XB_SPIN_CAP) { atomicAdd(&(bar)[XB_TMO], 1u); break; } } } } while (0)
__device__ __forceinline__ void xcd_barrier_complete(unsigned* bar, unsigned x, unsigned& nloc, unsigned& nx) {
    const unsigned G = gridDim.x * gridDim.y * gridDim.z;
    unsigned sum, cnt, mine, sp = 0u;
    for (;;) {
        sum = 0u; cnt = 0u; mine = 0u;
#pragma unroll
        for (unsigned j = 0; j < 16; ++j) { const unsigned c = xb_ld(&bar[XB_XCNT(j)]); sum += c; cnt += (c > 0u) ? 1u : 0u; mine = (j == x) ? c : mine; }
        if (sum == G) break;
        __builtin_amdgcn_s_sleep(1);
        if ((++sp & 255u) == 0u) { if (xb_ld(&bar[XB_TMO])) break; if (sp > XB_SPIN_CAP) { atomicAdd(&bar[XB_TMO], 1u); break; } }
    }
    nloc = mine > 0u ? mine : 1u; nx = cnt > 0u ? cnt : 1u;
}
__device__ __forceinline__ void xcd_barrier(unsigned* bar, unsigned nloc, unsigned nx, unsigned k, int wave_s) {
    asm volatile("s_waitcnt vmcnt(0)" ::: "memory");
    __syncthreads();
    if (opaque_tid(wave_s) == 0) {
        const unsigned x = xb_xcc_id();
        __builtin_amdgcn_s_waitcnt(0);
        const unsigned old = xb_add(&bar[XB_XSUB(x)], 1u);
        const unsigned gen = k;
        if (old + 1u == (gen + 1u) * nloc) {
            __builtin_amdgcn_fence(__ATOMIC_RELEASE, "agent");
            asm volatile("s_waitcnt vmcnt(0)" ::: "memory");
            const unsigned og = xb_add(&bar[XB_TOP], 1u);
            const unsigned tg = k;
            if (og + 1u == (tg + 1u) * nx) xb_add(&bar[XB_TOPGEN], 1u);
            else XB_SPIN(xb_ld(&bar[XB_TOPGEN]) == tg, bar);
            __builtin_amdgcn_fence(__ATOMIC_ACQUIRE, "agent");
            xb_add(&bar[XB_XGEN(x)], 1u);
            asm volatile("s_waitcnt vmcnt(0)" ::: "memory");
        } else {
            XB_SPIN(xb_ld(&bar[XB_XGEN(x)]) == gen, bar);
            __builtin_amdgcn_fence(__ATOMIC_ACQUIRE, "agent");
            asm volatile("s_waitcnt vmcnt(0)" ::: "memory");
        }
    }
    __syncthreads();
}

struct Args {
    const float* in[17];
    float* out; unsigned char* ws;
};

typedef __attribute__((address_space(4))) const char* karg_t;
__device__ __forceinline__ karg_t kargs() { karg_t p = (karg_t)__builtin_amdgcn_kernarg_segment_ptr(); asm volatile("" : "+s"(p)); return p; }
__device__ __forceinline__ const float* arg_in(int i) { return *(const float* const __attribute__((address_space(4)))*)(kargs() + 8 * i); }
__device__ __forceinline__ float* arg_out() { return *(float* const __attribute__((address_space(4)))*)(kargs() + 8 * 17); }
__device__ __forceinline__ unsigned char* arg_ws() { return *(unsigned char* const __attribute__((address_space(4)))*)(kargs() + 8 * 18); }
template <int MODE>
__device__ __forceinline__ int colmap(int n) {
    if (MODE == 1) {
        if (n < 512) return n;
        if (n < 1024) { const int j = n - 512, blk = j >> 6, p = j & 63; return 1536 + blk * 64 + (p >> 1) + 32 * (p & 1); }
        if (n < 1536) return 512 + (n - 1024);
        if (n < 2048) return 1024 + (n - 1536);
        if (n < 2560) { const int j = n - 2048, blk = j >> 6, p = j & 63; return 2048 + blk * 64 + (p >> 1) + 32 * (p & 1); }
        return n;
    }
    if (MODE == 2) { const int pn = n >> 8, bj = (n >> 7) & 1, j = n & 127; return bj * DFF + pn * 128 + j; }
    return n;
}
template <int MODE>
__device__ __forceinline__ void conv_mat(const float* src, int K, int N, bf16_t* dst, const float* scale, int gtid, int gthreads) {
    const int kch = K / 64; const long items = (long)N * kch;
    for (long it = gtid; it < items; it += gthreads) {
        const int n = (int)(it % N), k0 = (int)(it / N) * 64; const int sc = colmap<MODE>(n);
#pragma unroll
        for (int h = 0; h < 2; ++h) {
            float v[32];
#pragma unroll
            for (int j = 0; j < 32; ++j) v[j] = __builtin_nontemporal_load(src + (size_t)(k0 + h * 32 + j) * N + sc);
            if (scale) {
#pragma unroll
                for (int j = 0; j < 32; ++j) v[j] *= scale[k0 + h * 32 + j];
            }
#pragma unroll
            for (int q = 0; q < 4; ++q) { u32x4 w; w.x = cvt_pk_bf16(v[8 * q], v[8 * q + 1]); w.y = cvt_pk_bf16(v[8 * q + 2], v[8 * q + 3]); w.z = cvt_pk_bf16(v[8 * q + 4], v[8 * q + 5]); w.w = cvt_pk_bf16(v[8 * q + 6], v[8 * q + 7]);
                *(u32x4*)(dst + (size_t)n * K + k0 + h * 32 + 8 * q) = w; }
        }
    }
}
__device__ __forceinline__ void convert_layer(int l, unsigned char* wb, int gtid, int gthreads) {
    conv_mat<1>(arg_in(3) + (size_t)l * DM * NQKV, DM, NQKV, (bf16_t*)(wb + W_IN), arg_in(2) + (size_t)l * DM, gtid, gthreads);
    conv_mat<0>(arg_in(10) + (size_t)l * DM * DM, DM, DM, (bf16_t*)(wb + W_OUT), nullptr, gtid, gthreads);
    conv_mat<2>(arg_in(12) + (size_t)l * DM * NUP, DM, NUP, (bf16_t*)(wb + W_UP), arg_in(11) + (size_t)l * DM, gtid, gthreads);
    conv_mat<0>(arg_in(15) + (size_t)l * DFF * DM, DFF, DM, (bf16_t*)(wb + W_DOWN), nullptr, gtid, gthreads);
}

__global__ void __launch_bounds__(512, 2) mega_fwd(Args a) {
    extern __shared__ __attribute__((aligned(16))) unsigned char lds_raw[];
    LAS unsigned char* L = (LAS unsigned char*)lds_raw;
    cg::grid_group grid = cg::this_grid();
    const int G = gridDim.x, bx = blockIdx.x;
    const int wave_s = __builtin_amdgcn_readfirstlane((int)(threadIdx.x >> 6));
    { unsigned* barp = (unsigned*)(arg_ws() + WS_CTL); if (threadIdx.x == 0) (void)xb_add(&barp[XB_XCNT(xb_xcc_id())], 1u); }
    unsigned bar_nloc = 1u, bar_nx = 1u;
#define GRID_BAR(j) xcd_barrier((unsigned*)(arg_ws() + WS_CTL), bar_nloc, bar_nx, (unsigned)(1 + l * 6 + (j)), wave_s)
#define FRAME_IDS() const int tid = opaque_tid(wave_s), lane = tid & 63, wave = wave_s; \
    const int gtid = bx * 512 + tid, gthreads = G * 512, gw = bx * 8 + wave, NGW = G * 8; (void)lane; (void)gtid; (void)gthreads; (void)gw; (void)NGW
#define PTRS() unsigned char* ws = arg_ws(); bf16_t* QKV = (bf16_t*)(ws + WS_QKV); bf16_t* Hb = (bf16_t*)(ws + WS_QKV); bf16_t* XB = (bf16_t*)(ws + WS_XB); \
    float* HB = (float*)(ws + WS_HB); float* SSQ = (float*)(ws + WS_SSQ); f32x2* ROPE = (f32x2*)(ws + WS_ROPE); float* X = arg_out(); \
    (void)QKV; (void)Hb; (void)XB; (void)HB; (void)SSQ; (void)ROPE; (void)X

    {
    FRAME_IDS(); PTRS();
    for (int m = gw; m < M_TOK; m += NGW) {
        const float* src = (m < M_PROMPT) ? arg_in(0) + (size_t)m * DM : arg_in(1) + (size_t)(m - M_PROMPT) * DM;
        float s = 0.f;
        f32x4 xv[4];
#pragma unroll
        for (int j = 0; j < 4; ++j) xv[j] = __builtin_nontemporal_load((const f32x4*)(src + j * 256 + lane * 4));
#pragma unroll
        for (int j = 0; j < 4; ++j) { const f32x4 v = xv[j];
            u32x2 w; w.x = cvt_pk_bf16(v[0], v[1]); w.y = cvt_pk_bf16(v[2], v[3]); *(u32x2*)(XB + (size_t)m * DM + j * 256 + lane * 4) = w;
            const float r0 = __uint_as_float(w.x << 16), r1 = __uint_as_float(w.x & 0xffff0000u), r2 = __uint_as_float(w.y << 16), r3 = __uint_as_float(w.y & 0xffff0000u);
            s += (r0 * r0 + r1 * r1) + (r2 * r2 + r3 * r3); }
#pragma unroll
        for (int o = 1; o < 64; o <<= 1) s += __shfl_xor(s, o);
        if (lane < 16) SSQ[(size_t)m * 16 + lane] = (lane == 0) ? s : 0.f;
    }
    for (int i = gtid; i < 8192 * 32; i += gthreads) {
        const int t = i >> 5, fi = i & 31;
        const float invf = 1.0f / exp2f((float)fi * (13.287712379549449f / 32.0f));
        const float ang = (float)t * invf;
        double rev = (double)ang * 0.15915494309189535; rev -= floor(rev);
        const float fr = (float)rev;
        ROPE[i] = (f32x2){__builtin_amdgcn_cosf(fr), __builtin_amdgcn_sinf(fr)};
    }
    conv_mat<1>(arg_in(3), DM, NQKV, (bf16_t*)(ws + WS_W + W_IN), arg_in(2), gtid, gthreads);
    }
    if (gridDim.x == 0x7fffffffu) grid.sync();
    { unsigned* barp = (unsigned*)(arg_ws() + WS_CTL); unsigned nl, nx_; xcd_barrier_complete(barp, xb_xcc_id(), nl, nx_);
      bar_nloc = (unsigned)__builtin_amdgcn_readfirstlane((int)nl); bar_nx = (unsigned)__builtin_amdgcn_readfirstlane((int)nx_); }
    xcd_barrier((unsigned*)(arg_ws() + WS_CTL), bar_nloc, bar_nx, 0u, wave_s);

#define CONV_Q(ln_, cidx_, lo_, hi_) do { \
        unsigned char* ws_ = arg_ws(); unsigned* cctr = (unsigned*)(ws_ + WS_CTL) + 4048 + (cidx_); \
        unsigned char* wbn = ws_ + WS_W + (size_t)((ln_) & 1) * W_LAYER; const int ln = (ln_); \
        volatile LAS int* cslot = (volatile LAS int*)(L + LDS_BYTES - 16); \
        for (;;) { \
            __syncthreads(); \
            if (opaque_tid(wave_s) == 0) *cslot = (int)__hip_atomic_fetch_add(cctr, 1u, __ATOMIC_RELAXED, __HIP_MEMORY_SCOPE_AGENT); \
            __syncthreads(); \
            const int cb = (lo_) + __builtin_amdgcn_readfirstlane(*cslot); \
            if (cb >= (hi_)) break; \
            const int t = opaque_tid(wave_s); \
            if (cb < 96) conv_mat<1>(arg_in(3) + (size_t)ln * DM * NQKV, DM, NQKV, (bf16_t*)(wbn + W_IN), arg_in(2) + (size_t)ln * DM, cb * 512 + t, 1 << 30); \
            else if (cb < 128) conv_mat<0>(arg_in(10) + (size_t)ln * DM * DM, DM, DM, (bf16_t*)(wbn + W_OUT), nullptr, (cb - 96) * 512 + t, 1 << 30); \
            else if (cb < 304) conv_mat<2>(arg_in(12) + (size_t)ln * DM * NUP, DM, NUP, (bf16_t*)(wbn + W_UP), arg_in(11) + (size_t)ln * DM, (cb - 128) * 512 + t, 1 << 30); \
            else conv_mat<0>(arg_in(15) + (size_t)ln * DFF * DM, DFF, DM, (bf16_t*)(wbn + W_DOWN), nullptr, (cb - 304) * 512 + t, 1 << 30); \
        } } while (0)
#pragma unroll 1
    for (int l = 0; l < DEPTH; ++l) {
#define LPTRS() PTRS(); unsigned char* wb = ws + WS_W + (size_t)(l & 1) * W_LAYER; \
        const float* ssqA = SSQ + (size_t)(2 * l) * SSQ_STAGE; float* ssqB = SSQ + (size_t)(2 * l + 1) * SSQ_STAGE; float* ssqC = SSQ + (size_t)(2 * l + 2) * SSQ_STAGE; (void)wb; (void)ssqA; (void)ssqB; (void)ssqC
        { LPTRS(); pg8::Gemm g{XB, (const bf16_t*)(wb + W_IN), M_TOK, NQKV, DM, DM}; pg8::StaticOrder S; S.init(M_TOK, NQKV, G, bx);
          EpiInProj E{QKV, ssqA, ROPE}; pg8::gemm_phase<EpiInProj>(L, g, S, E, wave_s); }
        if (l == 0) CONV_Q(0, 4, 96, 392);
        GRID_BAR(0);
        {
            FRAME_IDS(); PTRS();
            const float* rpb = arg_in(4) + (size_t)l * 8 * 15 * 31;
            const float lam_init = 0.8f - 0.6f * expf(-0.3f * (float)l);
            float d1 = 0.f, d2 = 0.f;
            for (int i = 0; i < 64; ++i) { d1 += arg_in(5)[l * 64 + i] * arg_in(6)[l * 64 + i]; d2 += arg_in(7)[l * 64 + i] * arg_in(8)[l * 64 + i]; }
            const float lam = expf(d1) - expf(d2) + lam_init;
            const float* subg = arg_in(9) + (size_t)l * 128;
            __syncthreads();
            for (int u = opaque_s(bx); u < 512; u += G) {
                if (u < 256) {
                    const int x = u & 7, j = u >> 3; const int b = x >> 2, h = x & 3;
                    att::diff_unit(QKV, M_PROMPT + b * T_S, T_S, j * 256, h, lam, 1.0f - lam_init, subg, L, wave_s);
                } else {
                    const int v = u - 256, x = v & 7, j = v >> 3; const int bh = 2 * x + (j >> 4), b = bh >> 2, h = bh & 3;
                    att::diff_unit(QKV, b * T_P, T_P, (j & 15) * 256, h, lam, 1.0f - lam_init, subg, L, wave_s);
                }
            }
            {
                const bool xq = (G == 256);
                const int x0 = xq ? (bx & 7) : 0, qlen = xq ? 128 : 1024, nq = xq ? 8 : 1;
                unsigned* ctr0 = (unsigned*)(ws + WS_CTL) + 3520 + l * 128;
                volatile LAS int* slot = (volatile LAS int*)(L + 116736);
                int qi = 0;
                for (;;) {
                    const int x = (x0 + qi) & 7;
                    __syncthreads();
                    if (opaque_tid(wave_s) == 0) *slot = (int)__hip_atomic_fetch_add(ctr0 + x * 16, 1u, __ATOMIC_RELAXED, __HIP_MEMORY_SCOPE_AGENT);
                    __syncthreads();
                    const int n = __builtin_amdgcn_readfirstlane(*slot);
                    if (n >= qlen) { if (++qi >= nq) break; continue; }
                    int rpg = n >> 2, hp = n & 3;
                    if (xq) { const int kk = n >> 5, i = n & 31; rpg = (kk * 8 + x) * 8 + (i >> 2); hp = i & 3; }
                    const int sq = rpg < 128 ? 0 : 1, q = rpg - 128 * sq, b = sq ? (q >> 6) : (q >> 5);
                    att::na_unit(QKV, sq ? M_PROMPT + b * T_S : b * T_P, sq ? 128 : 64, sq ? (q & 63) : (q & 31), hp, rpb, L, wave_s);
                }
                if (l + 1 < DEPTH) CONV_Q(l + 1, l, 0, 392);
            }
        }
        GRID_BAR(1);
        { LPTRS(); pg8::Gemm g{QKV, (const bf16_t*)(wb + W_OUT), M_TOK, DM, DM, NQKV}; pg8::StaticOrder S; S.init(M_TOK, DM, G, bx);
          EpiResid E{XB, ssqB}; pg8::gemm_phase<EpiResid>(L, g, S, E, wave_s); }
        GRID_BAR(2);
        { LPTRS(); pg8::Gemm g{XB, (const bf16_t*)(wb + W_UP), M_TOK, NUP, DM, DM}; pg8::StaticOrder S; S.init(M_TOK, NUP, G, bx);
          EpiUp E{Hb, HB, ssqB, arg_in(13) + (size_t)l * 3 * DFF, arg_in(14) + (size_t)l * DFF}; pg8::gemm_phase<EpiUp>(L, g, S, E, wave_s); }
        GRID_BAR(3);
        {
            FRAME_IDS(); PTRS();
            const float* cw = arg_in(13) + (size_t)l * 3 * DFF;
            for (int i = gtid; i < 1024 * (DFF / 4); i += gthreads) {
                const int bi = i / (DFF / 4), cq = (i % (DFF / 4)) * 4, grp = bi >> 1, which = bi & 1;
                const int row = grp * 64 + (which ? 63 : 0);
                const float* hb = HB + (size_t)(bi * 3) * DFF + cq;
                f32x4 x = *(const f32x4*)hb; const f32x4 v = *(const f32x4*)(hb + DFF);
                const int nrow = which ? row + 1 : row;
                const bool seq_start = (nrow < M_PROMPT) ? ((nrow & (T_P - 1)) == 0) : ((nrow & (T_S - 1)) == 0);
                if (!seq_start) {
                    const int nbi = which ? (grp + 1) * 2 : (grp - 1) * 2 + 1;
                    const f32x4 nb = *(const f32x4*)(HB + (size_t)(nbi * 3 + 2) * DFF + cq);
                    const f32x4 w = *(const f32x4*)(cw + (which ? 2 * DFF : 0) + cq);
                    x += w * nb;
                }
                const f32x4 hval = gelu4(x) * v;
                u32x2 w2; w2.x = cvt_pk_bf16(hval[0], hval[1]); w2.y = cvt_pk_bf16(hval[2], hval[3]);
                *(u32x2*)(Hb + (size_t)row * DFF + cq) = w2;
            }
        }
        GRID_BAR(4);
        { LPTRS(); pg8::Gemm g{Hb, (const bf16_t*)(wb + W_DOWN), M_TOK, DM, DFF, DFF}; pg8::StaticOrder S; S.init(M_TOK, DM, G, bx);
          EpiResid E{XB, ssqC}; pg8::gemm_phase<EpiResid>(L, g, S, E, wave_s); }
        GRID_BAR(5);
    }
    {
        FRAME_IDS(); PTRS();
        const float* ssqF = SSQ + (size_t)8 * SSQ_STAGE; const float* gf = arg_in(16);
        for (int m = gw; m < M_TOK; m += NGW) {
            const float rs = rstd_row(ssqF, m);
#pragma unroll
            for (int j = 0; j < 4; ++j) { const u32x2 w = *(const u32x2*)(XB + (size_t)m * DM + j * 256 + lane * 4); const f32x4 gg = *(const f32x4*)(gf + j * 256 + lane * 4);
                const f32x4 v = {__uint_as_float(w.x << 16), __uint_as_float(w.x & 0xffff0000u), __uint_as_float(w.y << 16), __uint_as_float(w.y & 0xffff0000u)};
                __builtin_nontemporal_store(v * rs * gg, (f32x4*)(X + (size_t)m * DM + j * 256 + lane * 4)); }
        }
    }
}

extern "C" void kernel_launch(void* const* d_in, const int* in_sizes, int n_in, void* d_out, int out_size, void* d_ws, size_t ws_size, hipStream_t stream) {
    static int grid_blocks = 0;
    if (grid_blocks == 0) {
        if (n_in != 17 || out_size != M_TOK * DM || ws_size < WS_END) { fprintf(stderr, "kernel_launch: unexpected shapes / workspace (n_in %d out %d ws %zu need %zu)\n", n_in, out_size, ws_size, (size_t)WS_END); grid_blocks = -1; return; }
        int dev = 0, cus = 0, per_cu = 0;
        hipGetDevice(&dev);
        hipDeviceGetAttribute(&cus, hipDeviceAttributeMultiprocessorCount, dev);
        if (hipFuncSetAttribute((const void*)mega_fwd, hipFuncAttributeMaxDynamicSharedMemorySize, LDS_BYTES) != hipSuccess) { fprintf(stderr, "kernel_launch: hipFuncSetAttribute failed\n"); grid_blocks = -1; return; }
        if (hipOccupancyMaxActiveBlocksPerMultiprocessor(&per_cu, (const void*)mega_fwd, 512, LDS_BYTES) != hipSuccess || per_cu < 1) per_cu = 1;
        (void)hipGetLastError();
        grid_blocks = cus * per_cu;
    }
    if (grid_blocks < 0) return;
    if (hipMemsetAsync((char*)d_ws + WS_CTL, 0, CTL_BYTES, stream) != hipSuccess) { fprintf(stderr, "kernel_launch: memset of the barrier words failed\n"); return; }
    Args a{};
    for (int i = 0; i < 17; ++i) a.in[i] = (const float*)d_in[i];
    a.out = (float*)d_out; a.ws = (unsigned char*)d_ws;
    void* args[] = {&a};
    hipError_t e = hipLaunchCooperativeKernel((const void*)mega_fwd, dim3(grid_blocks), dim3(512), args, LDS_BYTES, stream);
    if (e != hipSuccess) fprintf(stderr, "cooperative launch failed: %s (grid %d)\n", hipGetErrorString(e), grid_blocks);
}
```
